# Optimizing an MI355X kernel written in HIP

```python
import math
import jax, jax.numpy as jnp
from jax import lax
import numpy as np

D_MODEL = 1024
BATCH = 2
SEQ = 8192
DEPTH = 4

N_MIXERS = 2
N_CONV_LAYERS = (DEPTH + N_MIXERS - 1) // N_MIXERS
N_NSA_LAYERS = DEPTH // N_MIXERS
D_FF = 2816
CONV_WIDTH = 3
NSA_HEADS = 16
HEAD_DIM = D_MODEL // NSA_HEADS
NSA_GROUPS = 4
HEADS_PER_GROUP = NSA_HEADS // NSA_GROUPS
KV_DIM = NSA_GROUPS * HEAD_DIM
CMP_BLOCK = 32
CMP_STRIDE = 16
CMP_HIDDEN = 256
SEL_BLOCK = 64
SEL_TOP_N = 16
WINDOW = 512
Q_BLOCK = 128
REL_BUCKETS = 32
REL_MAX_DIST = 128
NSA_IN_DIM = NSA_HEADS * HEAD_DIM + 6 * KV_DIM + 3 * NSA_HEADS
RMS_EPS = 1e-6
NEG_INF = -1e30
FORCE = 1e9
HALF = 0.5

kernel_name = "hybrid_conv_nsa_macaron_adaln"


def rms_norm(x, g):
    xf = x.astype(jnp.float32)
    y = xf * lax.rsqrt(jnp.mean(xf * xf, axis=-1, keepdims=True) + RMS_EPS)
    return (y * g.astype(jnp.float32)).astype(x.dtype)


def adaln(x, g, shift, scale):
    return rms_norm(x, g) * (1 + scale[:, None, :]) + shift[:, None, :]


def t5_bucket(dist):
    n = jnp.maximum(dist, 0)
    max_exact = REL_BUCKETS // 2
    nf = jnp.maximum(n, 1).astype(jnp.float32)
    large = max_exact + (jnp.log(nf / max_exact) / math.log(REL_MAX_DIST / max_exact)
                         * (REL_BUCKETS - max_exact)).astype(jnp.int32)
    large = jnp.minimum(large, REL_BUCKETS - 1)
    return jnp.where(n < max_exact, n, large)


def masked_softmax(logits, valid):
    p = jax.nn.softmax(jnp.where(valid, logits, NEG_INF), axis=-1)
    return jnp.where(valid, p, 0.0)


def swiglu(h, w_in, w_out):
    g, u = jnp.split(h @ w_in, 2, axis=-1)
    return (jax.nn.silu(g) * u) @ w_out


def short_conv_mixer(h, w_in, conv_w, w_out):
    b_gate, c_gate, v = jnp.split(h @ w_in, 3, axis=-1)
    u = c_gate * v
    y = lax.conv_general_dilated(
        u, conv_w[:, None, :].astype(u.dtype), window_strides=(1,),
        padding=[(CONV_WIDTH - 1, 0)], dimension_numbers=("NWC", "WIO", "NWC"),
        feature_group_count=D_MODEL)
    return (b_gate * y) @ w_out


def nsa_mixer(h, w_in, cmp_pos, cmp_w1, cmp_w2, q_gain, k_gain, w_out, rel_bias):
    bsz, seq, _ = h.shape
    G, Hg, hd = NSA_GROUPS, HEADS_PER_GROUP, HEAD_DIM
    n_cmp = (seq - CMP_BLOCK) // CMP_STRIDE + 1
    n_sel = seq // SEL_BLOCK
    n_top = min(SEL_TOP_N, n_sel)
    n_qblk = seq // Q_BLOCK
    scale = HEAD_DIM ** -0.5
    f32 = jnp.float32

    offs = [NSA_HEADS * HEAD_DIM + i * KV_DIM for i in range(7)]
    q, kc, vc, ks, vs, kw, vw, gl = jnp.split(h @ w_in, offs, axis=-1)
    q = rms_norm(q.reshape(bsz, seq, G, Hg, hd), q_gain).transpose(0, 2, 3, 1, 4)
    gates = jax.nn.sigmoid(gl.astype(f32)).reshape(bsz, seq, G, Hg, 3).transpose(0, 2, 3, 1, 4)

    def kv(t):
        return t.reshape(bsz, seq, G, hd)

    blk_idx = jnp.arange(n_cmp)[:, None] * CMP_STRIDE + jnp.arange(CMP_BLOCK)[None, :]

    def compress(t, w1, w2):
        blocks = kv(t)[:, blk_idx] + cmp_pos[None, None, :, None, :]
        flat = blocks.transpose(0, 3, 1, 2, 4).reshape(bsz, G, n_cmp, CMP_BLOCK * hd)
        return jax.nn.gelu(flat @ w1) @ w2

    k_cmp = rms_norm(compress(kc, cmp_w1[0], cmp_w2[0]), k_gain[0])
    v_cmp = compress(vc, cmp_w1[1], cmp_w2[1])
    k_sel = rms_norm(kv(ks), k_gain[1]).transpose(0, 2, 1, 3).reshape(bsz, G, n_sel, SEL_BLOCK, hd)
    v_sel = kv(vs).transpose(0, 2, 1, 3).reshape(bsz, G, n_sel, SEL_BLOCK, hd)
    pad = ((0, 0), (0, 0), (WINDOW, 0), (0, 0))
    k_win = jnp.pad(rms_norm(kv(kw), k_gain[2]).transpose(0, 2, 1, 3), pad)
    v_win = jnp.pad(kv(vw).transpose(0, 2, 1, 3), pad)

    rb = rel_bias.astype(f32).T.reshape(G, Hg, REL_BUCKETS)
    g_ix = jnp.arange(G)[None, :, None, None, None]
    h_ix = jnp.arange(Hg)[None, None, :, None, None]
    cmp_start = jnp.arange(n_cmp) * CMP_STRIDE
    cmp_end = cmp_start + CMP_BLOCK - 1
    sel_start = jnp.arange(n_sel) * SEL_BLOCK
    overlap = ((cmp_start[:, None] <= sel_start[None, :] + SEL_BLOCK - 1)
               & (cmp_end[:, None] >= sel_start[None, :])).astype(f32)
    sel_ids = jnp.arange(n_sel)
    gather = jax.vmap(jax.vmap(lambda kb, ib: kb[ib]))

    def block(qi):
        t0 = qi * Q_BLOCK
        t = t0 + jnp.arange(Q_BLOCK)
        qb = lax.dynamic_slice_in_dim(q, t0, Q_BLOCK, axis=3)
        gb = lax.dynamic_slice_in_dim(gates, t0, Q_BLOCK, axis=3)

        dist_c = t[:, None] - cmp_end[None, :]
        s_c = (jnp.einsum('bghqd,bgnd->bghqn', qb, k_cmp).astype(f32) * scale
               + rb[:, :, t5_bucket(dist_c)])
        p_c = masked_softmax(s_c, dist_c >= 0)
        o_c = jnp.einsum('bghqn,bgnd->bghqd', p_c.astype(v_cmp.dtype), v_cmp)

        imp = jnp.einsum('bghqn,ns->bgqs', p_c, overlap)
        cur = t // SEL_BLOCK
        forced = ((sel_ids[None, :] == 0) | (sel_ids[None, :] == cur[:, None])
                  | (sel_ids[None, :] == cur[:, None] - 1))
        imp = jnp.where(sel_start[None, :] > t[:, None], NEG_INF, imp)
        imp = jnp.where(forced, FORCE, imp)
        top = lax.top_k(imp, n_top)[1]
        kg = gather(k_sel, top).reshape(bsz, G, Q_BLOCK, n_top * SEL_BLOCK, hd)
        vg = gather(v_sel, top).reshape(bsz, G, Q_BLOCK, n_top * SEL_BLOCK, hd)
        pos_s = (top[..., None] * SEL_BLOCK + jnp.arange(SEL_BLOCK)).reshape(bsz, G, Q_BLOCK, -1)
        dist_s = t[:, None] - pos_s
        s_s = (jnp.einsum('bghqd,bgqkd->bghqk', qb, kg).astype(f32) * scale
               + rb[g_ix, h_ix, t5_bucket(dist_s)[:, :, None]])
        p_s = masked_softmax(s_s, (dist_s >= 0)[:, :, None])
        o_s = jnp.einsum('bghqk,bgqkd->bghqd', p_s.astype(vg.dtype), vg)

        kwb = lax.dynamic_slice_in_dim(k_win, t0, WINDOW + Q_BLOCK, axis=2)
        vwb = lax.dynamic_slice_in_dim(v_win, t0, WINDOW + Q_BLOCK, axis=2)
        pos_w = t0 - WINDOW + jnp.arange(WINDOW + Q_BLOCK)
        dist_w = t[:, None] - pos_w[None, :]
        valid_w = (dist_w >= 0) & (dist_w < WINDOW) & (pos_w[None, :] >= 0)
        s_w = (jnp.einsum('bghqd,bgkd->bghqk', qb, kwb).astype(f32) * scale
               + rb[:, :, t5_bucket(dist_w)])
        p_w = masked_softmax(s_w, valid_w)
        o_w = jnp.einsum('bghqk,bgkd->bghqd', p_w.astype(vwb.dtype), vwb)

        out = gb[..., 0:1] * o_c + gb[..., 1:2] * o_s + gb[..., 2:3] * o_w
        return out.astype(h.dtype)

    o = lax.map(block, jnp.arange(n_qblk))
    o = o.transpose(1, 0, 4, 2, 3, 5).reshape(bsz, seq, NSA_HEADS * HEAD_DIM)
    return o @ w_out


def setup_inputs(seed: int = 0) -> dict:
    key = jax.random.key(seed)
    ks = jax.random.split(key, 20)
    f32 = jnp.float32

    def nrm(k, shape, s):
        return jax.random.normal(k, shape, dtype=f32) * s

    return {
        "x": nrm(ks[0], (BATCH, SEQ, D_MODEL), 1.0),
        "c": nrm(ks[1], (BATCH, D_MODEL), 1.0),
        "norm_g": 1.0 + nrm(ks[2], (DEPTH, 3, D_MODEL), 0.02),
        "ada_w": nrm(ks[3], (DEPTH, D_MODEL, 9 * D_MODEL), 0.5 * D_MODEL ** -0.5),
        "ada_b": nrm(ks[4], (DEPTH, 9 * D_MODEL), 0.02),
        "ffn_w_in": nrm(ks[5], (DEPTH, 2, D_MODEL, 2 * D_FF), D_MODEL ** -0.5),
        "ffn_w_out": nrm(ks[6], (DEPTH, 2, D_FF, D_MODEL), D_FF ** -0.5),
        "conv_w_in": nrm(ks[7], (N_CONV_LAYERS, D_MODEL, 3 * D_MODEL), D_MODEL ** -0.5),
        "conv_w": nrm(ks[8], (N_CONV_LAYERS, CONV_WIDTH, D_MODEL), CONV_WIDTH ** -0.5),
        "conv_w_out": nrm(ks[9], (N_CONV_LAYERS, D_MODEL, D_MODEL), D_MODEL ** -0.5),
        "nsa_w_in": nrm(ks[10], (N_NSA_LAYERS, D_MODEL, NSA_IN_DIM), D_MODEL ** -0.5),
        "nsa_cmp_pos": nrm(ks[11], (N_NSA_LAYERS, CMP_BLOCK, HEAD_DIM), 0.5),
        "nsa_cmp_w1": nrm(ks[12], (N_NSA_LAYERS, 2, CMP_BLOCK * HEAD_DIM, CMP_HIDDEN), (CMP_BLOCK * HEAD_DIM) ** -0.5),
        "nsa_cmp_w2": nrm(ks[13], (N_NSA_LAYERS, 2, CMP_HIDDEN, HEAD_DIM), CMP_HIDDEN ** -0.5),
        "nsa_q_gain": 1.0 + nrm(ks[14], (N_NSA_LAYERS, HEAD_DIM), 0.02),
        "nsa_k_gain": 1.0 + nrm(ks[15], (N_NSA_LAYERS, 3, HEAD_DIM), 0.02),
        "nsa_w_out": nrm(ks[16], (N_NSA_LAYERS, D_MODEL, D_MODEL), D_MODEL ** -0.5),
        "rel_bias": nrm(ks[17], (REL_BUCKETS, NSA_HEADS), 0.5),
    }


def reference(x, c, norm_g, ada_w, ada_b, ffn_w_in, ffn_w_out, conv_w_in, conv_w, conv_w_out,
              nsa_w_in, nsa_cmp_pos, nsa_cmp_w1, nsa_cmp_w2, nsa_q_gain, nsa_k_gain, nsa_w_out,
              rel_bias):
    cond = jax.nn.silu(c)
    bsz = c.shape[0]
    for i in range(DEPTH):
        mod = (cond @ ada_w[i] + ada_b[i]).reshape(bsz, 3, 3, D_MODEL)
        shift, scl, gate = mod[:, :, 0], mod[:, :, 1], mod[:, :, 2]

        h = adaln(x, norm_g[i, 0], shift[:, 0], scl[:, 0])
        x = x + HALF * gate[:, 0, None, :] * swiglu(h, ffn_w_in[i, 0], ffn_w_out[i, 0])

        h = adaln(x, norm_g[i, 1], shift[:, 1], scl[:, 1])
        j = i // N_MIXERS
        if i % N_MIXERS == 0:
            y = short_conv_mixer(h, conv_w_in[j], conv_w[j], conv_w_out[j])
        else:
            y = nsa_mixer(h, nsa_w_in[j], nsa_cmp_pos[j], nsa_cmp_w1[j], nsa_cmp_w2[j],
                          nsa_q_gain[j], nsa_k_gain[j], nsa_w_out[j], rel_bias)
        x = x + gate[:, 1, None, :] * y

        h = adaln(x, norm_g[i, 2], shift[:, 2], scl[:, 2])
        x = x + HALF * gate[:, 2, None, :] * swiglu(h, ffn_w_in[i, 1], ffn_w_out[i, 1])
    return x
```

```cpp
#include <hip/hip_runtime.h>
#include <hip/hip_cooperative_groups.h>
#include <cstdint>
#include <cstdio>
namespace cg = cooperative_groups;

#ifndef MK_MULTI
#define MK_MULTI 0
#endif

#define DI __device__ __forceinline__
#define LAS __attribute__((address_space(3)))
typedef unsigned short bf16_t;
typedef short bf16x8 __attribute__((ext_vector_type(8)));
typedef float f32x4 __attribute__((ext_vector_type(4)));
typedef float f32x2 __attribute__((ext_vector_type(2)));
typedef unsigned u32x4 __attribute__((ext_vector_type(4)));
typedef unsigned u32x2 __attribute__((ext_vector_type(2)));
typedef __bf16 bf16x2_t __attribute__((ext_vector_type(2)));

constexpr int SEQ = 8192, TOK = 16384, DM = 1024, FF = 2816, FF2 = 5632;
constexpr int NSA_IN = 2608, NSA_P = 2816;
constexpr float RMS_EPS = 1e-6f;
__constant__ unsigned char PROG[] = {0,1,2,3,4,5,6,7,8,9,10,11,12,13,14,15,16,17,18,19,20,21,22,23,24,25,26,27,28,29,30,31,32,33,34,35,36,37,38,39,40,41,42,43,44,45,46};
constexpr int NPH = 47;

constexpr size_t MiB = 1u << 20;
constexpr size_t WS_MOD = 0;
constexpr size_t WS_BIAS1 = 512 * 1024;
constexpr size_t WS_ZERO_BYTES = 1 * MiB;
constexpr size_t WS_WFI = 2 * MiB;
constexpr size_t WS_WFO = 90 * MiB;
constexpr size_t WS_WCI = 134 * MiB;
constexpr size_t WS_WCO = 146 * MiB;
constexpr size_t WS_WNI = 150 * MiB;
constexpr size_t WS_WNO = 161 * MiB;
constexpr size_t WS_WC1 = 165 * MiB;
constexpr size_t WS_HB = 170 * MiB;
constexpr size_t WS_HID = 202 * MiB;
constexpr size_t WS_QN = 290 * MiB;
constexpr size_t WS_KCT = 322 * MiB;
constexpr size_t WS_KSEL = 339 * MiB;
constexpr size_t WS_KWIN = 347 * MiB;
constexpr size_t WS_VSELT = 355 * MiB;
constexpr size_t WS_VWINT = 363 * MiB;
constexpr size_t WS_H1 = 371 * MiB;
constexpr size_t WS_KCMP = 379 * MiB;
constexpr size_t WS_VCMPT = 380 * MiB;
constexpr size_t WS_GATES = 381 * MiB;
constexpr size_t WS_DUMMY = 384 * MiB;
constexpr size_t WS_XS = 448 * MiB;
constexpr size_t WS_CNT = 300 * 1024;
constexpr size_t WS_Y1 = 450 * MiB;
constexpr size_t WS_END = 466 * MiB;

constexpr int LDS_BYTES = 163840;

DI unsigned pk2(float lo, float hi) { f32x2 v = {lo, hi}; bf16x2_t b = __builtin_convertvector(v, bf16x2_t); return __builtin_bit_cast(unsigned, b); }
DI float lo_f(unsigned w) { return __uint_as_float(w << 16); }
DI float hi_f(unsigned w) { return __uint_as_float(w & 0xffff0000u); }
DI float bf2f(bf16_t h) { return __uint_as_float((unsigned)h << 16); }
DI float shx(float v, int off, int lane) { return __int_as_float(__builtin_amdgcn_ds_bpermute((lane ^ off) << 2, __float_as_int(v))); }
DI int shxi(int v, int off, int lane) { return __builtin_amdgcn_ds_bpermute((lane ^ off) << 2, v); }
DI float wave_sum(float v, int lane) {
#pragma unroll
    for (int o = 1; o < 64; o <<= 1) v += shx(v, o, lane);
    return v;
}
DI float sigmoidf_(float x) { return 1.0f / (1.0f + __expf(-x)); }

namespace pg8 {
constexpr int BM = 256, BK = 64, HALF = 128, HTB = HALF * BK * 2, STAGE_BYTES = 8 * HTB, NXCD = 8, WGM = 8;
__host__ __device__ __forceinline__ int lds_byte(int r, int c) { const int st = (r >> 4) * 2 + (c >> 5), rr = r & 15, cc = c & 31, ob = rr * 64 + cc * 2; return st * 1024 + (ob ^ (((ob >> 9) & 1) << 5)); }
__host__ __device__ __forceinline__ void stage_rc(int b, int& R, int& C) { const int st = b / 1024, sb = b % 1024, swz = sb ^ (((sb >> 9) & 1) << 5); R = (st >> 1) * 16 + swz / 64; C = (st & 1) * 32 + (swz % 64) / 2; }
__host__ __device__ __forceinline__ int perm32(int rho) { const int n = rho >> 4, i = rho & 15; return 8 * (i >> 2) + 4 * n + (i & 3); }

struct Unit { int pm, pn; };
struct Gemm { const bf16_t* A; const bf16_t* Bt; int lda, K; int bshift; size_t bstride; };

struct StaticOrder {
    int nM, nN, nwg, G, c;
    __device__ void init(int M, int N, int G_, int c_) { nM = M / BM; nN = N / BM; nwg = nM * nN; G = G_; c = c_; }
    __device__ bool next(int i, Unit& u) const {
        const long L = (long)i * G + c; if (L >= nwg) return false;
        int wgid = (int)L; { const int q = nwg / NXCD, r = nwg % NXCD, xcd = wgid % NXCD, off = wgid / NXCD; wgid = (xcd < r ? xcd * (q + 1) : r * (q + 1) + (xcd - r) * q) + off; }
        const int nig = WGM * nN, gid = wgid / nig, fm = gid * WGM, gsz = (nM - fm) < WGM ? (nM - fm) : WGM;
        u.pm = fm + ((wgid % nig) % gsz); u.pn = (wgid % nig) / gsz; return true;
    }
};

struct EpiSwiGLU {
    static constexpr bool PERM = true, AFTER_DRAIN = false;
    bf16_t* O;
    DI void operator()(const f32x4 (&acc)[2][2][4][2], const Unit& u, int wr, int wc, int fr, int fq) const {
        const int row0 = u.pm * BM + wr * 64 + fr, col0 = u.pn * 128 + wc * 32 + 8 * fq;
#pragma unroll
        for (int ai = 0; ai < 2; ++ai)
#pragma unroll
            for (int m = 0; m < 4; ++m) {
                bf16_t* rowp = O + (size_t)(row0 + ai * HALF + m * 16) * FF + col0;
                float v[8];
#pragma unroll
                for (int n = 0; n < 2; ++n)
#pragma unroll
                    for (int j = 0; j < 4; ++j) { const float g = acc[ai][0][m][n][j], up = acc[ai][1][m][n][j]; v[n * 4 + j] = g * up * __builtin_amdgcn_rcpf(1.0f + __expf(-g)); }
                u32x4 w; w.x = pk2(v[0], v[1]); w.y = pk2(v[2], v[3]); w.z = pk2(v[4], v[5]); w.w = pk2(v[6], v[7]);
                *(u32x4*)rowp = w;
            }
    }
};
struct EpiRes {
    static constexpr bool PERM = false, AFTER_DRAIN = false;
    const float* base; float* out; const float* gate; float coef;
    DI void operator()(const f32x4 (&acc)[2][2][4][2], const Unit& u, int wr, int wc, int fr, int fq) const {
        const int row0 = u.pm * BM + wr * 64 + fr, col0 = u.pn * BM + wc * 32 + 4 * fq, b = u.pm >> 5;
        f32x4 gv[2][2];
#pragma unroll
        for (int bj = 0; bj < 2; ++bj)
#pragma unroll
            for (int n = 0; n < 2; ++n) gv[bj][n] = *(const f32x4*)(gate + b * 9216 + col0 + bj * HALF + n * 16) * coef;
#pragma unroll
        for (int ai = 0; ai < 2; ++ai)
#pragma unroll
            for (int m = 0; m < 4; ++m) {
                const size_t off = (size_t)(row0 + ai * HALF + m * 16) * DM + col0;
#pragma unroll
                for (int bj = 0; bj < 2; ++bj)
#pragma unroll
                    for (int n = 0; n < 2; ++n) { const f32x4 bs = *(const f32x4*)(base + off + bj * HALF + n * 16); *(f32x4*)(out + off + bj * HALF + n * 16) = bs + gv[bj][n] * acc[ai][bj][m][n]; }
                if (m & 1) asm volatile("" ::: "memory");
            }
    }
};
struct EpiConvIn {
    static constexpr bool PERM = true, AFTER_DRAIN = false;
    bf16_t* U; bf16_t* Bg;
    DI void operator()(const f32x4 (&acc)[2][2][4][2], const Unit& u, int wr, int wc, int fr, int fq) const {
        const int row0 = u.pm * BM + wr * 64 + fr;
        if (u.pn < 8) {
            const int col0 = u.pn * 128 + wc * 32 + 8 * fq;
#pragma unroll
            for (int ai = 0; ai < 2; ++ai)
#pragma unroll
                for (int m = 0; m < 4; ++m) {
                    const f32x4 a = acc[ai][0][m][0] * acc[ai][1][m][0], c = acc[ai][0][m][1] * acc[ai][1][m][1];
                    u32x4 w; w.x = pk2(a[0], a[1]); w.y = pk2(a[2], a[3]); w.z = pk2(c[0], c[1]); w.w = pk2(c[2], c[3]);
                    *(u32x4*)(U + (size_t)(row0 + ai * HALF + m * 16) * DM + col0) = w;
                }
        } else {
            const int col0 = (u.pn - 8) * BM + wc * 32 + 8 * fq;
#pragma unroll
            for (int ai = 0; ai < 2; ++ai)
#pragma unroll
                for (int m = 0; m < 4; ++m)
#pragma unroll
                    for (int bj = 0; bj < 2; ++bj) {
                        const f32x4 a = acc[ai][bj][m][0], c = acc[ai][bj][m][1];
                        u32x4 w; w.x = pk2(a[0], a[1]); w.y = pk2(a[2], a[3]); w.z = pk2(c[0], c[1]); w.w = pk2(c[2], c[3]);
                        *(u32x4*)(Bg + (size_t)(row0 + ai * HALF + m * 16) * DM + col0 + bj * HALF) = w;
                    }
        }
    }
};
struct EpiPlain {
    static constexpr bool PERM = true, AFTER_DRAIN = false;
    bf16_t* O; int ldc;
    DI void operator()(const f32x4 (&acc)[2][2][4][2], const Unit& u, int wr, int wc, int fr, int fq) const {
        const int row0 = u.pm * BM + wr * 64 + fr, col0 = u.pn * BM + wc * 32 + 8 * fq;
#pragma unroll
        for (int ai = 0; ai < 2; ++ai)
#pragma unroll
            for (int m = 0; m < 4; ++m)
#pragma unroll
                for (int bj = 0; bj < 2; ++bj) {
                    const f32x4 a = acc[ai][bj][m][0], c = acc[ai][bj][m][1];
                    u32x4 w; w.x = pk2(a[0], a[1]); w.y = pk2(a[2], a[3]); w.z = pk2(c[0], c[1]); w.w = pk2(c[2], c[3]);
                    *(u32x4*)(O + (size_t)(row0 + ai * HALF + m * 16) * ldc + col0 + bj * HALF) = w;
                }
    }
};
struct EpiCmp {
    static constexpr bool PERM = false, AFTER_DRAIN = false;
    float* Y;
    DI void operator()(const f32x4 (&acc)[2][2][4][2], const Unit& u, int wr, int wc, int fr, int fq) const {
        const int row0 = u.pm * BM + wr * 64 + fr, col0 = u.pn * BM + wc * 32 + 4 * fq;
#pragma unroll
        for (int ai = 0; ai < 2; ++ai)
#pragma unroll
            for (int m = 0; m < 4; ++m)
#pragma unroll
                for (int bj = 0; bj < 2; ++bj)
#pragma unroll
                    for (int n = 0; n < 2; ++n) *(f32x4*)(Y + (size_t)(row0 + ai * HALF + m * 16) * 512 + col0 + bj * HALF + n * 16) = acc[ai][bj][m][n];
    }
};
struct EpiResNorm {
    static constexpr bool PERM = false, AFTER_DRAIN = true;
    const float* base; float* out; const float* gate;
    const float* ng; const float* nshift; bf16_t* H; float* xs; unsigned* cnt; float coef; int pad;
    DI void fused(f32x4 (&acc)[2][2][4][2], const Unit& u, int wr, int wc, int fr, int fq, LAS unsigned char* lds, int wid, int lane, int tid) const {
        const int row0 = u.pm * BM + wr * 64 + fr, col0 = u.pn * BM + wc * 32 + 4 * fq, b = u.pm >> 5;
        LAS float* P = (LAS float*)lds; LAS float* R = (LAS float*)(lds + 4096);
        {
            f32x4 gv[2][2];
#pragma unroll
            for (int bj = 0; bj < 2; ++bj)
#pragma unroll
                for (int n = 0; n < 2; ++n) gv[bj][n] = *(const f32x4*)(gate + b * 9216 + col0 + bj * HALF + n * 16) * coef;
#pragma unroll
            for (int ai = 0; ai < 2; ++ai)
#pragma unroll
                for (int m = 0; m < 4; ++m) {
                    const size_t off = (size_t)(row0 + ai * HALF + m * 16) * DM + col0; float sq = 0.f;
#pragma unroll
                    for (int bj = 0; bj < 2; ++bj)
#pragma unroll
                        for (int n = 0; n < 2; ++n) { const f32x4 bs = *(const f32x4*)(base + off + bj * HALF + n * 16); const f32x4 x = bs + gv[bj][n] * acc[ai][bj][m][n];
                            acc[ai][bj][m][n] = x; *(f32x4*)(out + off + bj * HALF + n * 16) = x; sq += (x[0] * x[0] + x[1] * x[1]) + (x[2] * x[2] + x[3] * x[3]); }
                    sq += shx(sq, 16, lane); sq += shx(sq, 32, lane);
                    if (fq == 0) P[(ai * HALF + wr * 64 + m * 16 + fr) * 4 + wc] = sq;
                    if (m == 3) asm volatile("" ::: "memory");
                }
        }
        __syncthreads();
        if (tid < 256) { const float tot = (P[tid * 4 + 0] + P[tid * 4 + 1]) + (P[tid * 4 + 2] + P[tid * 4 + 3]);
            __hip_atomic_store(xs + (size_t)(u.pm * BM + tid) * 4 + u.pn, tot, __ATOMIC_RELAXED, __HIP_MEMORY_SCOPE_AGENT); }
        asm volatile("s_waitcnt vmcnt(0)" ::: "memory");
        if (tid < 256 && lane == 0) __hip_atomic_fetch_add(cnt + 16 * u.pm, 1u, __ATOMIC_RELAXED, __HIP_MEMORY_SCOPE_AGENT);
        if (wid == 0) {
            unsigned sp = 0;
            while ((unsigned)__builtin_amdgcn_readfirstlane(__hip_atomic_load(cnt + 16 * u.pm, __ATOMIC_RELAXED, __HIP_MEMORY_SCOPE_AGENT)) < 16u) { __builtin_amdgcn_s_sleep(2); if (++sp > (1u << 22)) break; }
            __builtin_amdgcn_fence(__ATOMIC_ACQUIRE, "agent");
        }
        asm volatile("s_waitcnt vmcnt(0) lgkmcnt(0)" ::: "memory");
        __syncthreads();
        if (tid < 256) { const float* sl = xs + (size_t)(u.pm * BM + tid) * 4; float t = 0.f;
#pragma unroll
            for (int k = 0; k < 4; ++k) t += __hip_atomic_load(sl + k, __ATOMIC_RELAXED, __HIP_MEMORY_SCOPE_AGENT);
            R[tid] = rsqrtf(t * (1.f / DM) + RMS_EPS); }
        __syncthreads();
        const float* nsc = nshift + 1024;
#pragma unroll
        for (int bj = 0; bj < 2; ++bj)
#pragma unroll
            for (int n = 0; n < 2; ++n) {
                const int col = col0 + bj * HALF + n * 16;
                const f32x4 gg = *(const f32x4*)(ng + col), sc = *(const f32x4*)(nsc + b * 9216 + col), sh = *(const f32x4*)(nshift + b * 9216 + col);
                const f32x4 w = gg * (sc + 1.0f);
#pragma unroll
                for (int ai = 0; ai < 2; ++ai)
#pragma unroll
                    for (int m = 0; m < 4; ++m) {
                        const int rl = ai * HALF + wr * 64 + m * 16 + fr; const float r = R[rl];
                        const f32x4 y = acc[ai][bj][m][n] * r * w + sh;
                        u32x2 o; o.x = pk2(y[0], y[1]); o.y = pk2(y[2], y[3]);
                        *(u32x2*)(H + (size_t)(u.pm * BM + rl) * DM + col) = o;
                    }
            }
    }
};

template <class Epi, bool ALIGN_EPI>
__device__ __forceinline__ void gemm_phase(LAS unsigned char* lds, const Gemm& g, const StaticOrder& S, const Epi& E, const int tid) {
    const int wid = __builtin_amdgcn_readfirstlane(tid >> 6), lane = tid & 63, wr = wid >> 2, wc = wid & 3, fr = lane & 15, fq = lane >> 4;
    const int K = g.K, lda = g.lda, nt = K / BK;
    unsigned voffA[2], voffB[2];
#pragma unroll
    for (int i = 0; i < 2; ++i) { int R, C; stage_rc(tid * 16 + i * 8192, R, C); const int Rb = Epi::PERM ? ((R & ~31) + perm32(R & 31)) : R;
        voffA[i] = (unsigned)(R * lda + C) * 2u; voffB[i] = (unsigned)(Rb * K + C) * 2u; }
    const size_t kstep = (size_t)(BK * 2);
    const size_t hstepA = (size_t)HALF * lda * 2, hstepB = (size_t)HALF * K * 2;
    const size_t tstepA = 2 * hstepA, tstepB = 2 * hstepB;
    const unsigned ldsw = (unsigned)wid * 1024u;
    const int aoff = lds_byte(wr * 64 + fr, fq * 8), boff = lds_byte(wc * 32 + fr, fq * 8);
#define PG8_SA(b, h) (((b) * 2 + (h)) * HTB)
#define PG8_SB(b, h) ((4 + (b) * 2 + (h)) * HTB)
#define PG8_STAGE(bufoff, gbase, voff) do { _Pragma("unroll") for (int _i = 0; _i < 2; ++_i) \
        __builtin_amdgcn_global_load_lds((const unsigned*)((const char*)(gbase) + (voff)[_i]), (LAS unsigned*)(lds + (bufoff) + ldsw + _i * 8192), 16, 0, 0); } while (0)
#define PG8_LDA(dst, b, h) do { _Pragma("unroll") for (int m = 0; m < 4; ++m) _Pragma("unroll") for (int k = 0; k < 2; ++k) dst[m][k] = *(const LAS bf16x8*)(lds + PG8_SA(b, h) + aoff + m * 2048 + k * 1024); } while (0)
#define PG8_LDB(dst, b, h) do { _Pragma("unroll") for (int n = 0; n < 2; ++n) _Pragma("unroll") for (int k = 0; k < 2; ++k) dst[n][k] = *(const LAS bf16x8*)(lds + PG8_SB(b, h) + boff + n * 2048 + k * 1024); } while (0)
#define PG8_MMA(ai, bj, At, Bt) do { __builtin_amdgcn_s_setprio(1); _Pragma("unroll") for (int m = 0; m < 4; ++m) _Pragma("unroll") for (int n = 0; n < 2; ++n) _Pragma("unroll") for (int k = 0; k < 2; ++k) \
        acc[ai][bj][m][n] = __builtin_amdgcn_mfma_f32_16x16x32_bf16(Bt[n][k], At[m][k], acc[ai][bj][m][n], 0, 0, 0); __builtin_amdgcn_s_setprio(0); } while (0)
#define PG8_WAIT_V(n) asm volatile("s_waitcnt vmcnt(" #n ")" ::: "memory")
#define PG8_WAIT_L(n) asm volatile("s_waitcnt lgkmcnt(" #n ")" ::: "memory")
#define PG8_BAR __builtin_amdgcn_s_barrier()
#define PG8_SCHED __builtin_amdgcn_sched_barrier(0)
#define PG8_ABASE(u) ((const char*)g.A + (size_t)(u).pm * tstepA)
#define PG8_BBASE(u) ((const char*)g.Bt + (size_t)(u).pn * tstepB + (size_t)((u).pm >> g.bshift) * g.bstride * 2)
    Unit cur, nxt; int ui = 0;
    if (!S.next(0, cur)) return;
    f32x4 acc[2][2][4][2];
#pragma unroll
    for (int a = 0; a < 2; ++a)
#pragma unroll
        for (int b = 0; b < 2; ++b)
#pragma unroll
            for (int m = 0; m < 4; ++m)
#pragma unroll
                for (int n = 0; n < 2; ++n) acc[a][b][m][n] = (f32x4){0.f, 0.f, 0.f, 0.f};
    bf16x8 At[4][2], B0[2][2], B1[2][2];
    const char* cA = PG8_ABASE(cur); const char* cB = PG8_BBASE(cur);
    PG8_STAGE(PG8_SB(0, 0), cB, voffB); PG8_STAGE(PG8_SB(0, 1), cB + hstepB, voffB); PG8_STAGE(PG8_SA(0, 0), cA, voffA); PG8_STAGE(PG8_SA(0, 1), cA + hstepA, voffA);
    if (wr == 1) PG8_BAR;
    PG8_WAIT_V(2); PG8_BAR;
    PG8_STAGE(PG8_SB(1, 0), cB + kstep, voffB); PG8_STAGE(PG8_SA(1, 0), cA + kstep, voffA); PG8_STAGE(PG8_SB(1, 1), cB + hstepB + kstep, voffB);
    PG8_WAIT_V(6); PG8_BAR;
    for (;;) {
        const bool has_next = S.next(ui + 1, nxt);
        const char* nA = has_next ? PG8_ABASE(nxt) : cA; const char* nB = has_next ? PG8_BBASE(nxt) : cB;
        for (int t = 0; t < nt; t += 2) {
            const bool last = (t == nt - 2);
            const char* a1 = cA + (size_t)(t + 1) * kstep;
            const char* a2 = last ? nA : cA + (size_t)(t + 2) * kstep; const char* b2 = last ? nB : cB + (size_t)(t + 2) * kstep;
            const char* a3 = a2 + kstep; const char* b3 = b2 + kstep;
            PG8_LDB(B0, 0, 0); PG8_LDB(B1, 0, 1); PG8_SCHED; PG8_LDA(At, 0, 0); PG8_STAGE(PG8_SA(1, 1), a1 + hstepA, voffA);
            PG8_WAIT_V(8); PG8_WAIT_L(0); PG8_BAR; PG8_MMA(0, 0, At, B0); PG8_MMA(0, 1, At, B1); PG8_BAR; PG8_SCHED;
            PG8_LDA(At, 0, 1); PG8_STAGE(PG8_SB(0, 0), b2, voffB); PG8_STAGE(PG8_SB(0, 1), b2 + hstepB, voffB); PG8_STAGE(PG8_SA(0, 0), a2, voffA);
            PG8_WAIT_V(8); PG8_WAIT_L(0); PG8_BAR; PG8_MMA(1, 0, At, B0); PG8_MMA(1, 1, At, B1); PG8_BAR; PG8_SCHED;
            PG8_LDB(B0, 1, 0); PG8_LDB(B1, 1, 1); PG8_SCHED; PG8_LDA(At, 1, 0); PG8_STAGE(PG8_SA(0, 1), a2 + hstepA, voffA);
            PG8_WAIT_V(8); PG8_WAIT_L(0); PG8_BAR; PG8_MMA(0, 0, At, B0); PG8_MMA(0, 1, At, B1); PG8_BAR; PG8_SCHED;
            PG8_LDA(At, 1, 1); PG8_STAGE(PG8_SB(1, 0), b3, voffB); PG8_STAGE(PG8_SB(1, 1), b3 + hstepB, voffB); PG8_STAGE(PG8_SA(1, 0), a3, voffA);
            PG8_WAIT_V(8); PG8_WAIT_L(0); PG8_BAR; PG8_MMA(1, 0, At, B0); PG8_MMA(1, 1, At, B1); PG8_BAR; PG8_SCHED;
        }
        if constexpr (ALIGN_EPI) { if (wr == 0) PG8_BAR; }
        if constexpr (!Epi::AFTER_DRAIN) E(acc, cur, wr, wc, fr, fq);
        if (!has_next) break;
#pragma unroll
        for (int a = 0; a < 2; ++a)
#pragma unroll
            for (int b = 0; b < 2; ++b)
#pragma unroll
                for (int m = 0; m < 4; ++m)
#pragma unroll
                    for (int n = 0; n < 2; ++n) acc[a][b][m][n] = (f32x4){0.f, 0.f, 0.f, 0.f};
        cur = nxt; cA = nA; cB = nB; ++ui;
        if constexpr (ALIGN_EPI) { if (wr == 1) PG8_BAR; }
    }
    PG8_WAIT_V(0);
    if constexpr (!ALIGN_EPI) { if (wr == 0) PG8_BAR; }
    PG8_BAR;
    if constexpr (Epi::AFTER_DRAIN) E.fused(acc, cur, wr, wc, fr, fq, lds, wid, lane, tid);
#undef PG8_SA
#undef PG8_SB
#undef PG8_STAGE
#undef PG8_LDA
#undef PG8_LDB
#undef PG8_MMA
#undef PG8_WAIT_V
#undef PG8_WAIT_L
#undef PG8_BAR
#undef PG8_SCHED
#undef PG8_ABASE
#undef PG8_BBASE
}
}

struct Args {
    const float* x; const float* c; const float* norm_g; const float* ada_w; const float* ada_b; const float* ffn_w_in; const float* ffn_w_out;
    const float* conv_w_in; const float* conv_w; const float* conv_w_out; const float* nsa_w_in; const float* cmp_pos; const float* cmp_w1; const float* cmp_w2;
    const float* q_gain; const float* k_gain; const float* nsa_w_out; const float* rel_bias;
    float* out; unsigned char* ws; unsigned char* ws0; int ph_lo, ph_hi;
};

DI int dest_row(int mode, int n) {
    if (mode == 0) return n;
    if (mode == 1) { const int hi = n >= FF, j = hi ? n - FF : n; return (j >> 7) * 256 + hi * 128 + (j & 127); }
    if (n < 1024) return 2048 + n;
    const int hi = n >= 2048, j = n - 1024 - hi * 1024; return (j >> 7) * 256 + hi * 128 + (j & 127);
}
struct TrItem { const float* W; bf16_t* WT; int K, N, k0, n0, mode; };
DI void tr_load(const TrItem& t, f32x4 (&v)[8], int tid) {
    const int n = t.n0 + (tid & 63) * 4, kr = tid >> 6;
#pragma unroll
    for (int i = 0; i < 8; ++i) v[i] = (n < t.N) ? *(const f32x4*)(t.W + (size_t)(t.k0 + kr + 8 * i) * t.N + n) : (f32x4){0.f, 0.f, 0.f, 0.f};
}
DI void tr_to_lds(LAS float* tile, const f32x4 (&v)[8], int tid) {
    const int nn = (tid & 63) * 4, kr = tid >> 6;
#pragma unroll
    for (int i = 0; i < 8; ++i) { LAS float* p = tile + (kr + 8 * i) * 257 + nn; p[0] = v[i].x; p[1] = v[i].y; p[2] = v[i].z; p[3] = v[i].w; }
}
DI void tr_store(const TrItem& t, const LAS float* tile, int tid) {
#pragma unroll
    for (int j = 0; j < 4; ++j) { const int id = tid + 512 * j, kc = id & 7, n = id >> 3;
        const LAS float* s = tile + (kc * 8) * 257 + n;
        u32x4 o; o.x = pk2(s[0 * 257], s[1 * 257]); o.y = pk2(s[2 * 257], s[3 * 257]); o.z = pk2(s[4 * 257], s[5 * 257]); o.w = pk2(s[6 * 257], s[7 * 257]);
        if (t.mode == 3) *(u32x4*)(t.WT + (size_t)(t.n0 + n + ((t.k0 >> 10) << 8)) * 1024 + (t.k0 & 1023) + kc * 8) = o;
        else *(u32x4*)(t.WT + (size_t)dest_row(t.mode, t.n0 + n) * t.K + t.k0 + kc * 8) = o; }
}
DI void tr_kind(const float* W, bf16_t* WT, int nmtx, int K, int N, int NP, int mode, int cum, LAS float* tile, int tid) {
    const int nkb = K / 64, nnb = NP / 256, per = nkb * nnb, total = nmtx * per, G = gridDim.x;
    int it = ((int)blockIdx.x - cum % G + G) % G;
    f32x4 v[8];
    TrItem t; t.K = K; t.N = N; t.mode = mode;
    if (it < total) { const int mtx = it / per, q = it % per; t.W = W + (size_t)mtx * K * N; t.WT = WT + (size_t)mtx * NP * K; t.k0 = (q / nnb) * 64; t.n0 = (q % nnb) * 256; tr_load(t, v, tid); }
    for (; it < total; it += G) {
        tr_to_lds(tile, v, tid);
        __syncthreads();
        const TrItem tc = t;
        const int nx = it + G;
        if (nx < total) { const int mtx = nx / per, q = nx % per; t.W = W + (size_t)mtx * K * N; t.WT = WT + (size_t)mtx * NP * K; t.k0 = (q / nnb) * 64; t.n0 = (q % nnb) * 256; tr_load(t, v, tid); }
        tr_store(tc, tile, tid);
        __syncthreads();
    }
}

DI void phase_prologue(const Args& a, LAS unsigned char* lds, int tid, int wid, int lane, bool dummy) {
    float* mod = (float*)(a.ws + (dummy ? WS_DUMMY : WS_MOD)); float* bias1 = (float*)(a.ws + (dummy ? WS_DUMMY + 2 * MiB : WS_BIAS1));
    for (int it = blockIdx.x; it < 576 + 32; it += gridDim.x) {
        if (it < 576) {
            const int i = it / 144, r = it % 144, kc = r / 9, jb = r % 9;
            const int col = jb * 1024 + (tid & 255) * 4, kh = tid >> 8, kbeg = kc * 64 + kh * 32;
            f32x4 s0 = {0.f, 0.f, 0.f, 0.f}, s1 = {0.f, 0.f, 0.f, 0.f};
            const float* wp = a.ada_w + ((size_t)i * 1024 + kbeg) * 9216 + col;
#pragma unroll 8
            for (int k = 0; k < 32; ++k) {
                const f32x4 w = *(const f32x4*)(wp + (size_t)k * 9216);
                const float c0 = a.c[kbeg + k], c1 = a.c[1024 + kbeg + k];
                s0 += w * (c0 * sigmoidf_(c0)); s1 += w * (c1 * sigmoidf_(c1));
            }
            if (kc == 0 && kh == 0) { const f32x4 bb = *(const f32x4*)(a.ada_b + i * 9216 + col); s0 += bb; s1 += bb; }
            float* m0 = mod + (size_t)(i * 2 + 0) * 9216 + col; float* m1 = mod + (size_t)(i * 2 + 1) * 9216 + col;
#pragma unroll
            for (int e = 0; e < 4; ++e) { atomicAdd(m0 + e, s0[e]); atomicAdd(m1 + e, s1[e]); }
        } else if (tid < 256) {
            const int r = it - 576, lk = r >> 3, part = r & 7, l = lk >> 1;
            const float* pos = a.cmp_pos + (size_t)l * 2048 + part * 256;
            const float* w = a.cmp_w1 + ((size_t)lk * 2048 + part * 256) * 256 + tid;
            float s = 0.f;
#pragma unroll 8
            for (int k = 0; k < 256; ++k) s += pos[k] * w[(size_t)k * 256];
            atomicAdd(bias1 + lk * 256 + tid, s);
        }
    }
    {
        LAS float* tile = (LAS float*)lds;
        constexpr int C0 = 0, C1 = C0 + 8 * 16 * 22, C2 = C1 + 8 * 44 * 4, C3 = C2 + 2 * 16 * 12, C4 = C3 + 2 * 16 * 4, C5 = C4 + 2 * 16 * 11, C6 = C5 + 2 * 16 * 4;
        tr_kind(a.ffn_w_in, (bf16_t*)(a.ws + WS_WFI), 8, DM, FF2, FF2, 1, C0, tile, tid);
        tr_kind(a.ffn_w_out, (bf16_t*)(a.ws + WS_WFO), 8, FF, DM, DM, 0, C1, tile, tid);
        tr_kind(a.conv_w_in, (bf16_t*)(a.ws + WS_WCI), 2, DM, 3072, 3072, 2, C2, tile, tid);
        tr_kind(a.conv_w_out, (bf16_t*)(a.ws + WS_WCO), 2, DM, DM, DM, 0, C3, tile, tid);
        tr_kind(a.nsa_w_in, (bf16_t*)(a.ws + WS_WNI), 2, DM, NSA_IN, NSA_P, 0, C4, tile, tid);
        tr_kind(a.nsa_w_out, (bf16_t*)(a.ws + WS_WNO), 2, DM, DM, DM, 0, C5, tile, tid);
        tr_kind(a.cmp_w1, (bf16_t*)(a.ws + WS_WC1), 4, 2048, 256, 256, 3, C6, tile, tid);
    }
}

DI void phase_norm(const float* x, const float* g, const float* modL  , int sub, bf16_t* H, int wid, int lane) {
    const int gw = blockIdx.x * 8 + wid, NGW = gridDim.x * 8;
    for (int row = gw; row < TOK; row += NGW) {
        const int b = row >> 13;
        const float* sh = modL + b * 9216 + (sub * 3 + 0) * 1024; const float* sc = sh + 1024;
        const f32x4* xr = (const f32x4*)(x + (size_t)row * DM) + lane;
        f32x4 v[4]; float s = 0.f;
#pragma unroll
        for (int j = 0; j < 4; ++j) { v[j] = xr[64 * j]; s += (v[j].x * v[j].x + v[j].y * v[j].y) + (v[j].z * v[j].z + v[j].w * v[j].w); }
        const float rstd = rsqrtf(wave_sum(s, lane) * (1.f / DM) + RMS_EPS);
        u32x2* o8 = (u32x2*)(H + (size_t)row * DM) + lane;
#pragma unroll
        for (int j = 0; j < 4; ++j) {
            const f32x4 gg = ((const f32x4*)g)[lane + 64 * j], ss = ((const f32x4*)sc)[lane + 64 * j], hh = ((const f32x4*)sh)[lane + 64 * j];
            const f32x4 y = v[j] * rstd * gg * (ss + 1.0f) + hh;
            u32x2 w; w.x = pk2(y.x, y.y); w.y = pk2(y.z, y.w); o8[64 * j] = w;
        }
    }
}

DI void phase_conv_ew(const bf16_t* U, const bf16_t* Bg, const float* cw  , bf16_t* Wb, int tid) {
    const int gt = blockIdx.x * 512 + tid, NT = gridDim.x * 512;
    for (int idx = gt; idx < TOK * 128; idx += NT) {
        const int row = idx >> 7, c8 = (idx & 127) * 8, t = row & (SEQ - 1);
        const u32x4 u0 = *(const u32x4*)(U + (size_t)row * DM + c8);
        u32x4 u1 = {0u, 0u, 0u, 0u}, u2 = {0u, 0u, 0u, 0u};
        if (t >= 1) u1 = *(const u32x4*)(U + (size_t)(row - 1) * DM + c8);
        if (t >= 2) u2 = *(const u32x4*)(U + (size_t)(row - 2) * DM + c8);
        const u32x4 bg = *(const u32x4*)(Bg + (size_t)row * DM + c8);
        float k0[8], k1[8], k2[8];
        { const f32x4 a0 = *(const f32x4*)(cw + c8), a1 = *(const f32x4*)(cw + c8 + 4), b0 = *(const f32x4*)(cw + 1024 + c8), b1 = *(const f32x4*)(cw + 1024 + c8 + 4),
                      c0 = *(const f32x4*)(cw + 2048 + c8), c1 = *(const f32x4*)(cw + 2048 + c8 + 4);
#pragma unroll
          for (int j = 0; j < 4; ++j) { k0[j] = a0[j]; k0[4 + j] = a1[j]; k1[j] = b0[j]; k1[4 + j] = b1[j]; k2[j] = c0[j]; k2[4 + j] = c1[j]; } }
        u32x4 o;
#pragma unroll
        for (int e = 0; e < 4; ++e) {
            const float ylo = k0[2 * e] * lo_f(u2[e]) + k1[2 * e] * lo_f(u1[e]) + k2[2 * e] * lo_f(u0[e]);
            const float yhi = k0[2 * e + 1] * hi_f(u2[e]) + k1[2 * e + 1] * hi_f(u1[e]) + k2[2 * e + 1] * hi_f(u0[e]);
            o[e] = pk2(lo_f(bg[e]) * ylo, hi_f(bg[e]) * yhi);
        }
        *(u32x4*)(Wb + (size_t)row * DM + c8) = o;
    }
}

DI void norm64_store(const bf16_t* src, const float* gain, float mul, bf16_t* dst) {
    u32x4 v[8]; float ss = 0.f;
#pragma unroll
    for (int i = 0; i < 8; ++i) { v[i] = ((const u32x4*)src)[i];
#pragma unroll
        for (int e = 0; e < 4; ++e) { const float a = lo_f(v[i][e]), b = hi_f(v[i][e]); ss += a * a + b * b; } }
    const float r = rsqrtf(ss * (1.f / 64.f) + RMS_EPS) * mul;
#pragma unroll
    for (int i = 0; i < 8; ++i) { u32x4 o;
#pragma unroll
        for (int e = 0; e < 4; ++e) o[e] = pk2(lo_f(v[i][e]) * r * gain[i * 8 + 2 * e], hi_f(v[i][e]) * r * gain[i * 8 + 2 * e + 1]);
        ((u32x4*)dst)[i] = o; }
}
DI void phase_nsa_prep(const Args& a, int lj, LAS unsigned char* lds, int tid) {
    const int lane = tid & 63;
    const bf16_t* P = (const bf16_t*)(a.ws + WS_HID);
    bf16_t* Qn = (bf16_t*)(a.ws + WS_QN); bf16_t* KcT = (bf16_t*)(a.ws + WS_KCT); bf16_t* Ksel = (bf16_t*)(a.ws + WS_KSEL); bf16_t* Kwin = (bf16_t*)(a.ws + WS_KWIN);
    bf16_t* VselT = (bf16_t*)(a.ws + WS_VSELT); bf16_t* VwinT = (bf16_t*)(a.ws + WS_VWINT); float* Gates = (float*)(a.ws + WS_GATES);
    const float* qg = a.q_gain + lj * 64; const float* kg = a.k_gain + lj * 192;
    LAS bf16_t* tl = (LAS bf16_t*)lds;
    for (int u = blockIdx.x; u < TOK / 64; u += gridDim.x) {
        const int rowbase = u * 64, b = rowbase >> 13, tb = rowbase & (SEQ - 1);
#pragma unroll 4
        for (int it = 0; it < 16; ++it) {
            const int item = tid + it * 512, ch = item & 7, head = (item >> 3) & 15, tok = item >> 7;
            const u32x4 v = *(const u32x4*)(P + (size_t)(rowbase + tok) * NSA_P + head * 64 + ch * 8);
            float ss = 0.f;
#pragma unroll
            for (int e = 0; e < 4; ++e) { const float x0 = lo_f(v[e]), x1 = hi_f(v[e]); ss += x0 * x0 + x1 * x1; }
            ss += shx(ss, 1, lane); ss += shx(ss, 2, lane); ss += shx(ss, 4, lane);
            const float r = rsqrtf(ss * (1.f / 64.f) + RMS_EPS) * (0.125f * 1.4426950408889634f);
            u32x4 o;
#pragma unroll
            for (int e = 0; e < 4; ++e) o[e] = pk2(lo_f(v[e]) * r * qg[ch * 8 + 2 * e], hi_f(v[e]) * r * qg[ch * 8 + 2 * e + 1]);
            *(u32x4*)(Qn + (size_t)(rowbase + tok) * DM + head * 64 + ch * 8) = o;
        }
#pragma unroll 4
        for (int it = 0; it < 8; ++it) {
            const int item = tid + it * 512, ch = item & 7, g = (item >> 3) & 3, kind = (item >> 5) & 1, tok = item >> 6;
            const u32x4 v = *(const u32x4*)(P + (size_t)(rowbase + tok) * NSA_P + (kind ? 2048 : 1536) + g * 64 + ch * 8);
            float ss = 0.f;
#pragma unroll
            for (int e = 0; e < 4; ++e) { const float x0 = lo_f(v[e]), x1 = hi_f(v[e]); ss += x0 * x0 + x1 * x1; }
            ss += shx(ss, 1, lane); ss += shx(ss, 2, lane); ss += shx(ss, 4, lane);
            const float r = rsqrtf(ss * (1.f / 64.f) + RMS_EPS);
            const float* gn = kg + (1 + kind) * 64 + ch * 8;
            u32x4 o;
#pragma unroll
            for (int e = 0; e < 4; ++e) o[e] = pk2(lo_f(v[e]) * r * gn[2 * e], hi_f(v[e]) * r * gn[2 * e + 1]);
            *(u32x4*)((kind ? Kwin : Ksel) + ((size_t)(b * 4 + g) * SEQ + tb + tok) * 64 + ch * 8) = o;
            const u32x4 w = *(const u32x4*)(P + (size_t)(rowbase + tok) * NSA_P + 1024 + kind * 256 + g * 64 + ch * 8);
            *(u32x4*)(KcT + ((size_t)(kind * 8 + b * 4 + g) * SEQ + tb + tok) * 64 + ch * 8) = w;
        }
        for (int kind = 0; kind < 2; ++kind) {
            const int cbase = kind ? 2304 : 1792; bf16_t* VT = kind ? VwinT : VselT;
#pragma unroll
            for (int k = 0; k < 4; ++k) { const int idx = tid + k * 512, tok = idx >> 5, c16 = idx & 31;
                *(LAS u32x4*)(tl + tok * 264 + c16 * 8) = *(const u32x4*)(P + (size_t)(rowbase + tok) * NSA_P + cbase + c16 * 8); }
            __syncthreads();
#pragma unroll
            for (int k = 0; k < 4; ++k) { const int idx = tid + k * 512, col = idx >> 3, ch = idx & 7;
                unsigned short e[8];
#pragma unroll
                for (int j = 0; j < 8; ++j) e[j] = tl[(ch * 8 + j) * 264 + col];
                u32x4 o; o.x = e[0] | ((unsigned)e[1] << 16); o.y = e[2] | ((unsigned)e[3] << 16); o.z = e[4] | ((unsigned)e[5] << 16); o.w = e[6] | ((unsigned)e[7] << 16);
                *(u32x4*)(VT + ((size_t)(b * 4 + (col >> 6)) * 64 + (col & 63)) * SEQ + tb + ch * 8) = o; }
            __syncthreads();
        }
        for (int idx = tid; idx < 64 * 48; idx += 512) { const int tok = idx / 48, c = idx % 48;
            Gates[(size_t)(rowbase + tok) * 48 + c] = sigmoidf_(bf2f(P[(size_t)(rowbase + tok) * NSA_P + 2560 + c])); }
    }
}

DI void phase_cmp2(const Args& a, int lj, LAS unsigned char* lds, int tid, int wid, int lane) {
    const float* H1 = (const float*)(a.ws + WS_Y1); const float* bias1 = (const float*)(a.ws + WS_BIAS1) + lj * 512; bf16_t* Kcmp = (bf16_t*)(a.ws + WS_KCMP); bf16_t* VcmpT = (bf16_t*)(a.ws + WS_VCMPT);
    LAS float* w2s = (LAS float*)lds;
    { const f32x4* src = (const f32x4*)(a.cmp_w2 + (size_t)lj * 2 * 256 * 64);
#pragma unroll 4
      for (int i = tid; i < 8192; i += 512) { const f32x4 v = src[i]; LAS float* d = w2s + i * 4; d[0] = v.x; d[1] = v.y; d[2] = v.z; d[3] = v.w; } }
    __syncthreads();
    const int gw = blockIdx.x * 8 + wid, NGW = gridDim.x * 8;
    for (int r = gw; r < 8192; r += NGW) {
        const int z = r >> 9, n = r & 511, kind = z >> 3, bg = z & 7;
        float acc = 0.f;
        if (n < 511) {
            f32x4 hv = *((const f32x4*)(H1 + (size_t)r * 512) + lane) + *((const f32x4*)(H1 + (size_t)(r + 1) * 512 + 256) + lane) + *((const f32x4*)(bias1 + kind * 256) + lane);
#pragma unroll
            for (int e = 0; e < 4; ++e) { const float t = hv[e], uu = 0.7978845608f * (t + 0.044715f * t * t * t); hv[e] = t * __builtin_amdgcn_rcpf(1.0f + __expf(-2.0f * uu)); }
            const LAS float* w = w2s + kind * 16384 + lane;
#pragma unroll 4
            for (int l = 0; l < 64; ++l) {
                const float h0 = __int_as_float(__builtin_amdgcn_readlane(__float_as_int(hv.x), l)), h1 = __int_as_float(__builtin_amdgcn_readlane(__float_as_int(hv.y), l)), h2 = __int_as_float(__builtin_amdgcn_readlane(__float_as_int(hv.z), l)), h3 = __int_as_float(__builtin_amdgcn_readlane(__float_as_int(hv.w), l));
                acc += h0 * w[(4 * l) * 64]; acc += h1 * w[(4 * l + 1) * 64]; acc += h2 * w[(4 * l + 2) * 64]; acc += h3 * w[(4 * l + 3) * 64];
            }
        }
        if (kind == 0) {
            const float ss = wave_sum(acc * acc, lane);
            const float y = acc * rsqrtf(ss * (1.f / 64.f) + RMS_EPS) * a.k_gain[lj * 192 + lane];
            Kcmp[((size_t)bg * 512 + n) * 64 + lane] = (bf16_t)(pk2(y, 0.f) & 0xffffu);
        } else {
            VcmpT[((size_t)bg * 64 + lane) * 512 + n] = (bf16_t)(pk2(acc, 0.f) & 0xffffu);
        }
    }
}

DI int t5_bucket(int n) {
    if (n < 16) return n;
    int b = 16;
    b += (n >= 19) + (n >= 21) + (n >= 24) + (n >= 27) + (n >= 31) + (n >= 35) + (n >= 40) + (n >= 46) + (n >= 52) + (n >= 59) + (n >= 67) + (n >= 77) + (n >= 87) + (n >= 99) + (n >= 113);
    return b;
}
#define MFMA16(a, b, c) __builtin_amdgcn_mfma_f32_16x16x32_bf16((a), (b), (c), 0, 0, 0)

constexpr int AT_LUT = 0, AT_UM = 8256, AT_IMP = 8448, AT_Q = 74752, AT_STG = 140288, AT_STGV = AT_STG + 9216, AT_END = AT_STGV + 9216;
static_assert(AT_END <= LDS_BYTES, "attention LDS map");
constexpr int SROW = 144;

template <int KIND, bool DO_L, bool DO_IMP, bool DO_PV>
DI void attn_step(const LAS unsigned char* kst, const LAS unsigned char* vst, int key0, int token, int t0, bool selbit,
                  const bf16x8 (&Qf)[4][2], f32x4 (&acc)[4][4], float (&l)[4], const float (&pn)[4],
                  const LAS float* lut, const f32x4 b31, LAS float* impw, int c, int q) {
    bf16x8 Pf[4]; unsigned plo[4][2];
    const int maxkey = key0 + 31;
    bool far = (KIND == 0) ? (t0 - (16 * maxkey + 31) >= 128) : (t0 - maxkey >= 128);
    if (KIND == 3) far = far && (t0 + 15 - key0 < 512);
    const float mv = (KIND == 2 && far && !selbit) ? -1e30f : 0.f;
    const f32x4 cm = {mv, mv, mv, mv};
    bf16x8 kf[2][2];
#pragma unroll
    for (int sub = 0; sub < 2; ++sub) { const LAS unsigned char* kp = kst + (16 * sub + c) * SROW + q * 16; kf[sub][0] = *(const LAS bf16x8*)kp; kf[sub][1] = *(const LAS bf16x8*)(kp + 64); }
#pragma unroll
    for (int sub = 0; sub < 2; ++sub) {
        const int kbase = key0 + 16 * sub;
        const bf16x8 k0 = kf[sub][0], k1 = kf[sub][1];
        f32x4 S[4];
#pragma unroll
        for (int hg = 0; hg < 4; ++hg) { S[hg] = MFMA16(k0, Qf[hg][0], cm); S[hg] = MFMA16(k1, Qf[hg][1], S[hg]); }
        float pv[4][4]; float ia = 0.f, ib = 0.f;
        if (far) {
#pragma unroll
            for (int i = 0; i < 4; ++i)
#pragma unroll
                for (int hg = 0; hg < 4; ++hg) {
                    float p = __builtin_amdgcn_exp2f(S[hg][i]);
                    if (DO_L) l[hg] += p;
                    if (DO_IMP) p *= pn[hg];
                    if (DO_IMP) { ia += p; if (i == 3) ib += p; }
                    pv[hg][i] = p;
                }
        } else {
#pragma unroll
            for (int i = 0; i < 4; ++i) {
                const int kidx = kbase + 4 * q + i;
                int dist; bool valid;
                if (KIND == 0) { dist = token - (16 * kidx + 31); valid = dist >= 0; }
                else if (KIND == 2) { dist = token - kidx; valid = selbit && dist >= 0; }
                else { dist = token - kidx; valid = dist >= 0 && dist < 512; }
                const int di = dist < 0 ? 0 : (dist > 128 ? 128 : dist);
                const f32x4 b4 = *(const LAS f32x4*)(lut + di * 16);
#pragma unroll
                for (int hg = 0; hg < 4; ++hg) {
                    float p = valid ? __builtin_amdgcn_exp2f(S[hg][i] + b4[hg]) : 0.f;
                    if (DO_L) l[hg] += p;
                    if (DO_IMP) p *= pn[hg];
                    if (DO_IMP) { ia += p; if (i == 3) ib += p; }
                    pv[hg][i] = p;
                }
            }
        }
        if (DO_IMP) {
            const int s = (kbase >> 2) + q;
            impw[c * 129 + s] += ia;
            asm volatile("" ::: "memory");
            if (s + 1 < 128) impw[c * 129 + s + 1] += ib;
            asm volatile("" ::: "memory");
        }
        if (DO_PV) {
#pragma unroll
            for (int hg = 0; hg < 4; ++hg) {
                const unsigned w0 = pk2(pv[hg][0], pv[hg][1]), w1 = pk2(pv[hg][2], pv[hg][3]);
                if (sub == 0) { plo[hg][0] = w0; plo[hg][1] = w1; }
                else { u32x4 w = {plo[hg][0], plo[hg][1], w0, w1}; Pf[hg] = __builtin_bit_cast(bf16x8, w); }
            }
        }
    }
    if (DO_PV) {
        bf16x8 Vf[4];
#pragma unroll
        for (int dt = 0; dt < 4; ++dt) { const LAS unsigned char* vp = vst + (16 * dt + c) * SROW + q * 8;
            const u32x2 lo = *(const LAS u32x2*)vp, hi = *(const LAS u32x2*)(vp + 32); const u32x4 vv = {lo.x, lo.y, hi.x, hi.y}; Vf[dt] = __builtin_bit_cast(bf16x8, vv); }
        __builtin_amdgcn_sched_barrier(0);
#pragma unroll
        for (int dt = 0; dt < 4; ++dt)
#pragma unroll
            for (int hg = 0; hg < 4; ++hg) acc[hg][dt] = MFMA16(Vf[dt], Pf[hg], acc[hg][dt]);
    }
}

typedef unsigned long long u64;
DI bool um_bit(u64 lo, u64 hi, int s) { const u64 w = (s < 64) ? lo : hi; return ((w >> (s & 63)) & 1ull) != 0ull; }

template <int KIND, bool DO_L, bool DO_IMP, bool DO_PV>
DI void attn_stream(const bf16_t* __restrict__ Kg, const bf16_t* __restrict__ Vtg, int vstride, int blk_lo, int blk_hi, u64 uml, u64 umh, const LAS unsigned* selw,
                    int ti, int token, int t0, LAS unsigned char* lds, const bf16x8 (&Qf)[4][2], f32x4 (&acc)[4][4], float (&l)[4], const float (&pn)[4],
                    const LAS float* lut, const f32x4 b31, LAS float* impw, int c, int q, int tid) {
    const int srow = tid >> 3, sch = tid & 7;
    const int soff = srow * SROW + sch * 16;
    constexpr bool DB = !DO_IMP;
    constexpr int ALT = AT_IMP - AT_STG;
    int blk = blk_lo;
    if (KIND == 2) while (blk <= blk_hi && !um_bit(uml, umh, blk)) ++blk;
    u32x4 rk = {0u, 0u, 0u, 0u}, rv = {0u, 0u, 0u, 0u};
    if (blk <= blk_hi) { rk = *(const u32x4*)(Kg + (size_t)(64 * blk + srow) * 64 + sch * 8); if (DO_PV) rv = *(const u32x4*)(Vtg + (size_t)srow * vstride + 64 * blk + sch * 8); }
    int boff = 0;
    if (DB) { *(LAS u32x4*)(lds + AT_STG + soff) = rk; if (DO_PV) *(LAS u32x4*)(lds + AT_STGV + soff) = rv; __syncthreads(); }
#pragma unroll 1
    while (blk <= blk_hi) {
        if (!DB) { *(LAS u32x4*)(lds + AT_STG + soff) = rk; if (DO_PV) *(LAS u32x4*)(lds + AT_STGV + soff) = rv; __syncthreads(); }
        int nb = blk + 1;
        if (KIND == 2) while (nb <= blk_hi && !um_bit(uml, umh, nb)) ++nb;
        if (nb <= blk_hi) { rk = *(const u32x4*)(Kg + (size_t)(64 * nb + srow) * 64 + sch * 8); if (DO_PV) rv = *(const u32x4*)(Vtg + (size_t)srow * vstride + 64 * nb + sch * 8); }
        bool sb = true;
        if (KIND == 2) sb = ((selw[c * 4 + (blk >> 5)] >> (blk & 31)) & 1u) != 0u && (64 * blk <= token);
#pragma unroll 1
        for (int hh = 0; hh < 2; ++hh) {
            const int key0 = 64 * blk + 32 * hh;
            bool need;
            if (KIND == 0) need = key0 <= ti - 1;
            else if (KIND == 2) need = __ballot(sb) != 0ull;
            else need = (key0 <= t0 + 15) && (key0 + 31 >= t0 - 511);
            if (need) attn_step<KIND, DO_L, DO_IMP, DO_PV>(lds + AT_STG + boff + hh * 32 * SROW, lds + AT_STGV + boff + hh * 64, key0, token, t0, sb, Qf, acc, l, pn, lut, b31, impw, c, q);
        }
        if (DB) { boff ^= ALT; if (nb <= blk_hi) { *(LAS u32x4*)(lds + AT_STG + boff + soff) = rk; if (DO_PV) *(LAS u32x4*)(lds + AT_STGV + boff + soff) = rv; } }
        __syncthreads();
        blk = nb;
    }
}

DI void phase_attn(const Args& a, LAS unsigned char* lds, int tid, int wid, int lane) {
    LAS float* lutall = (LAS float*)(lds + AT_LUT);
    LAS unsigned* umw = (LAS unsigned*)(lds + AT_UM);
    LAS float* impw = (LAS float*)(lds + AT_IMP) + wid * (16 * 129);
    LAS unsigned char* qs = lds + AT_Q + wid * 8192 + lane * 16;
    for (int i = tid; i < 129 * 16; i += 512) { const int d = i >> 4, h = i & 15; lutall[i] = (a.rel_bias[t5_bucket(d) * 16 + h] - a.rel_bias[31 * 16 + h]) * 1.4426950408889634f; }
    __syncthreads();
    const int c = lane & 15, q = lane >> 4;
    if (wid >= 4) __builtin_amdgcn_s_setprio(1);
#pragma unroll 1
    for (int pidx = blockIdx.x; pidx < 256; pidx += gridDim.x) {
        const int bg = pidx >> 5, jj = pidx & 31, b = bg >> 2, g = bg & 3;
        size_t zoff = 0; asm volatile("" : "+s"(zoff)); unsigned char* wsl = a.ws + zoff;
        const bf16_t* Qn = (const bf16_t*)(wsl + WS_QN); const bf16_t* Ksel = (const bf16_t*)(wsl + WS_KSEL) + (size_t)bg * SEQ * 64; const bf16_t* Kwin = (const bf16_t*)(wsl + WS_KWIN) + (size_t)bg * SEQ * 64;
        const bf16_t* VselT = (const bf16_t*)(wsl + WS_VSELT) + (size_t)bg * 64 * SEQ; const bf16_t* VwinT = (const bf16_t*)(wsl + WS_VWINT) + (size_t)bg * 64 * SEQ;
        const bf16_t* Kc = (const bf16_t*)(wsl + WS_KCMP) + (size_t)bg * 512 * 64; const bf16_t* Vc = (const bf16_t*)(wsl + WS_VCMPT) + (size_t)bg * 64 * 512;
        const float* Gates = (const float*)(wsl + WS_GATES); bf16_t* O = (bf16_t*)(wsl + WS_HB);
        const LAS float* lut = lutall + g * 4;
        f32x4 b31;
#pragma unroll
        for (int hg = 0; hg < 4; ++hg) b31[hg] = a.rel_bias[31 * 16 + g * 4 + hg] * 1.4426950408889634f;
#pragma unroll 1
        for (int which = 0; which < 2; ++which) {
            const int tb = which ? 63 - jj : jj, ti = tb * 8 + wid, t0 = ti * 16, token = t0 + c;
            const size_t row = (size_t)b * SEQ + token;
            const float* grow = Gates + row * 48 + g * 12;
            bf16x8 Qf[4][2];
#pragma unroll
            for (int k = 0; k < 8; ++k) Qf[k >> 1][k & 1] = *(const bf16x8*)(Qn + row * DM + (g * 4 + (k >> 1)) * 64 + (k & 1) * 32 + 8 * q);
            if (tid < 4) umw[tid] = 0u;
            f32x4 acc[4][4];
            float l[4] = {0.f, 0.f, 0.f, 0.f}, pn[4] = {1.f, 1.f, 1.f, 1.f}, pnc[4];
            u64 uml = 0ull, umh = 0ull;
            LAS unsigned* selw = (LAS unsigned*)(lds + AT_Q) + wid * 64;
            const int cblk_hi = (tb * 8 + 7 - 1) >> 6;
            float* park = (float*)(wsl + WS_DUMMY) + row * DM + (size_t)g * 256 + 4 * q;
#pragma unroll
            for (int hg = 0; hg < 4; ++hg)
#pragma unroll
                for (int dt = 0; dt < 4; ++dt) acc[hg][dt] = (f32x4){0.f, 0.f, 0.f, 0.f};
            attn_stream<0, true, false, true>(Kc, Vc, 512, 0, cblk_hi, uml, umh, selw, ti, token, t0, lds, Qf, acc, l, pn, lut, b31, impw, c, q, tid);
#pragma unroll
            for (int hg = 0; hg < 4; ++hg) { float s = l[hg]; s += shx(s, 16, lane); s += shx(s, 32, lane); pnc[hg] = s > 0.f ? 1.0f / s : 0.f; l[hg] = 0.f;
                const float f = pnc[hg] * grow[hg * 3 + 0];
#pragma unroll
                for (int dt = 0; dt < 4; ++dt) *(f32x4*)(park + hg * 64 + dt * 16) = acc[hg][dt] * f; }
            for (int i = lane; i < 16 * 129; i += 64) impw[i] = 0.f;
            attn_stream<0, false, true, false>(Kc, Vc, 512, 0, cblk_hi, uml, umh, selw, ti, token, t0, lds, Qf, acc, l, pnc, lut, b31, impw, c, q, tid);
            unsigned selm = 0u;
            {
                const int cur = token >> 6;
                float NEGI = -1e30f, FORCE = 1e9f, GONE = -3e38f; asm volatile("" : "+v"(NEGI), "+v"(FORCE), "+v"(GONE));
                float v[32];
                const int cr = cur - 32 * q; const bool q0 = (q == 0); const LAS float* ip = impw + c * 129 + 32 * q;
#pragma unroll
                for (int k = 0; k < 32; ++k) { float x = ip[k];
                    if (k > cr) x = NEGI;
                    if ((k == 0 && q0) || k == cr || k == cr - 1) x = FORCE;
                    v[k] = x; }
#pragma unroll 1
                for (int r = 0; r < 16; ++r) {
                    float best = v[0]; int bi = 0;
#pragma unroll
                    for (int k = 1; k < 32; ++k) { if (v[k] > best) { best = v[k]; bi = k; } }
                    int gi = 32 * q + bi;
#pragma unroll
                    for (int off = 16; off <= 32; off <<= 1) { const float ob = shx(best, off, lane); const int oi = shxi(gi, off, lane); if (ob > best || (ob == best && oi < gi)) { best = ob; gi = oi; } }
                    const bool mine = (gi >> 5) == q; const int kk = gi & 31;
#pragma unroll
                    for (int k = 0; k < 32; ++k) if (mine && k == kk) v[k] = GONE;
                    if (mine) selm |= 1u << kk;
                }
            }
            selw[c * 4 + q] = selm;
            atomicOr((unsigned*)(umw + q), selm);
            __syncthreads();
            { const unsigned u0 = __builtin_amdgcn_readfirstlane(umw[0]), u1 = __builtin_amdgcn_readfirstlane(umw[1]), u2 = __builtin_amdgcn_readfirstlane(umw[2]), u3 = __builtin_amdgcn_readfirstlane(umw[3]);
              uml = (u64)u0 | ((u64)u1 << 32); umh = (u64)u2 | ((u64)u3 << 32); }
            {
                int wlo = tb * 128 - 511; if (wlo < 0) wlo = 0; wlo >>= 6;
#pragma unroll
                for (int hg = 0; hg < 4; ++hg)
#pragma unroll
                    for (int dt = 0; dt < 4; ++dt) acc[hg][dt] = (f32x4){0.f, 0.f, 0.f, 0.f};
                attn_stream<3, true, false, true>(Kwin, VwinT, SEQ, wlo, 2 * tb + 1, uml, umh, selw, ti, token, t0, lds, Qf, acc, l, pn, lut, b31, impw, c, q, tid);
#pragma unroll
                for (int hg = 0; hg < 4; ++hg) { float s = l[hg]; s += shx(s, 16, lane); s += shx(s, 32, lane); const float f = s > 0.f ? grow[hg * 3 + 2] / s : 0.f; l[hg] = 0.f;
#pragma unroll
                    for (int dt = 0; dt < 4; ++dt) { f32x4* pp = (f32x4*)(park + hg * 64 + dt * 16); *pp = *pp + acc[hg][dt] * f; } }
            }
#pragma unroll
            for (int hg = 0; hg < 4; ++hg)
#pragma unroll
                for (int dt = 0; dt < 4; ++dt) acc[hg][dt] = (f32x4){0.f, 0.f, 0.f, 0.f};
            attn_stream<2, true, false, true>(Ksel, VselT, SEQ, 0, 2 * tb + 1, uml, umh, selw, ti, token, t0, lds, Qf, acc, l, pn, lut, b31, impw, c, q, tid);
#pragma unroll
            for (int hg = 0; hg < 4; ++hg) { float s = l[hg]; s += shx(s, 16, lane); s += shx(s, 32, lane); const float f = s > 0.f ? grow[hg * 3 + 1] / s : 0.f; l[hg] = 0.f;
#pragma unroll
                for (int dt = 0; dt < 4; ++dt) acc[hg][dt] = acc[hg][dt] * f + *(const f32x4*)(park + hg * 64 + dt * 16); }
#pragma unroll
            for (int hg = 0; hg < 4; ++hg)
#pragma unroll
                for (int dt = 0; dt < 4; ++dt) { u32x2 w; w.x = pk2(acc[hg][dt][0], acc[hg][dt][1]); w.y = pk2(acc[hg][dt][2], acc[hg][dt][3]);
                    *(u32x2*)(O + row * DM + (g * 4 + hg) * 64 + 16 * dt + 4 * q) = w; }
        }
    }
    __builtin_amdgcn_s_setprio(0);
}


#ifdef SELFTEST
constexpr size_t WS_FLAG = 900 * 1024;
DI void phase_selftest(const Args& a, LAS unsigned char* lds, int wid, int lane) {
    const bf16_t* Qn = (const bf16_t*)(a.ws + WS_QN); const float* Gates = (const float*)(a.ws + WS_GATES); const bf16_t* O = (const bf16_t*)(a.ws + WS_HB);
    LAS float* W = (LAS float*)(lds + wid * 16384);
    LAS float* qv = W; LAS float* pc = W + 64; LAS float* imp = W + 576; LAS float* ps = W + 704; LAS float* pw = W + 1728; LAS float* outv = W + 2240; LAS int* sels = (LAS int*)(W + 2496);
    const float L2E = 1.4426950408889634f;
    const int gw = blockIdx.x * 8 + wid, NGW = gridDim.x * 8;
    for (int task = gw; task < 8 * 144; task += NGW) {
        const int bg = task / 144, k = task % 144, b = bg >> 2, g = bg & 3;
        int t;
        if (k < 128) t = k * 64 + (k * 37) % 64;
        else { const int ed[16] = {0, 1, 15, 30, 31, 32, 47, 63, 64, 65, 511, 512, 513, 4095, 4096, 8191}; t = ed[k - 128]; }
        const size_t row = (size_t)b * SEQ + t;
        const bf16_t* Kc = (const bf16_t*)(a.ws + WS_KCMP) + (size_t)bg * 512 * 64; const bf16_t* Vc = (const bf16_t*)(a.ws + WS_VCMPT) + (size_t)bg * 64 * 512;
        const bf16_t* Ks = (const bf16_t*)(a.ws + WS_KSEL) + (size_t)bg * SEQ * 64; const bf16_t* Vs = (const bf16_t*)(a.ws + WS_VSELT) + (size_t)bg * 64 * SEQ;
        const bf16_t* Kw = (const bf16_t*)(a.ws + WS_KWIN) + (size_t)bg * SEQ * 64; const bf16_t* Vw = (const bf16_t*)(a.ws + WS_VWINT) + (size_t)bg * 64 * SEQ;
        for (int i = lane; i < 128; i += 64) imp[i] = 0.f;
        for (int i = lane; i < 256; i += 64) outv[i] = 0.f;
        const int ncv = (t >= 31) ? (t - 31) / 16 + 1 : 0;
        for (int hg = 0; hg < 4; ++hg) {
            const int h = g * 4 + hg;
            qv[lane] = bf2f(Qn[row * DM + h * 64 + lane]);
            float lsum = 0.f;
            for (int n = lane; n < 512; n += 64) {
                float p = 0.f;
                if (n < ncv) { float sdot = 0.f; for (int d = 0; d < 64; ++d) sdot += qv[d] * bf2f(Kc[n * 64 + d]);
                    const int dist = t - (16 * n + 31); p = exp2f(sdot + a.rel_bias[t5_bucket(dist) * 16 + h] * L2E); }
                pc[n] = p; lsum += p;
            }
            lsum = wave_sum(lsum, lane);
            const float inv = lsum > 0.f ? 1.f / lsum : 0.f;
            for (int n = lane; n < 512; n += 64) pc[n] *= inv;
            for (int s2 = lane; s2 < 128; s2 += 64) { float acc = 0.f; for (int n = 4 * s2 - 1; n <= 4 * s2 + 3; ++n) if (n >= 0 && n < 511) acc += pc[n]; imp[s2] += acc; }
            { float o = 0.f; for (int n = 0; n < ncv; ++n) o += pc[n] * bf2f(Vc[lane * 512 + n]); outv[hg * 64 + lane] += Gates[row * 48 + h * 3 + 0] * o; }
        }
        const int cur = t >> 6;
        float v0, v1;
        { int s0 = lane, s1 = lane + 64; v0 = imp[s0]; v1 = imp[s1];
          if (s0 > cur) v0 = -1e30f; if (s1 > cur) v1 = -1e30f;
          if (s0 == 0 || s0 == cur || s0 == cur - 1) v0 = 1e9f; if (s1 == cur || s1 == cur - 1) v1 = 1e9f; }
        for (int r = 0; r < 16; ++r) {
            float best = v0; int bi = lane; if (v1 > best) { best = v1; bi = lane + 64; }
            for (int off = 1; off < 64; off <<= 1) { const float ob = shx(best, off, lane); const int oi = shxi(bi, off, lane); if (ob > best || (ob == best && oi < bi)) { best = ob; bi = oi; } }
            if (bi == lane) v0 = -3e38f; if (bi == lane + 64) v1 = -3e38f;
            if (lane == 0) sels[r] = bi;
        }
        for (int hg = 0; hg < 4; ++hg) {
            const int h = g * 4 + hg;
            qv[lane] = bf2f(Qn[row * DM + h * 64 + lane]);
            float lsum = 0.f;
            for (int r = 0; r < 16; ++r) {
                const int sb = sels[r], pos = sb * 64 + lane; float p = 0.f;
                if (pos <= t) { float sdot = 0.f; for (int d = 0; d < 64; ++d) sdot += qv[d] * bf2f(Ks[(size_t)pos * 64 + d]); p = exp2f(sdot + a.rel_bias[t5_bucket(t - pos) * 16 + h] * L2E); }
                ps[r * 64 + lane] = p; lsum += p;
            }
            lsum = wave_sum(lsum, lane);
            { float o = 0.f; for (int r = 0; r < 16; ++r) { const int sb = sels[r]; if (sb * 64 > t) continue; for (int kk = 0; kk < 64; ++kk) o += ps[r * 64 + kk] * bf2f(Vs[(size_t)lane * SEQ + sb * 64 + kk]); }
              outv[hg * 64 + lane] += (lsum > 0.f ? Gates[row * 48 + h * 3 + 1] / lsum : 0.f) * o; }
            lsum = 0.f;
            for (int j = lane; j < 512; j += 64) { const int pos = t - j; float p = 0.f;
                if (pos >= 0) { float sdot = 0.f; for (int d = 0; d < 64; ++d) sdot += qv[d] * bf2f(Kw[(size_t)pos * 64 + d]); p = exp2f(sdot + a.rel_bias[t5_bucket(j) * 16 + h] * L2E); }
                pw[j] = p; lsum += p; }
            lsum = wave_sum(lsum, lane);
            { float o = 0.f; for (int j = 0; j < 512; ++j) { const int pos = t - j; if (pos < 0) break; o += pw[j] * bf2f(Vw[(size_t)lane * SEQ + pos]); }
              outv[hg * 64 + lane] += (lsum > 0.f ? Gates[row * 48 + h * 3 + 2] / lsum : 0.f) * o; }
        }
        float mx = 0.f, md = 0.f;
        for (int i = lane; i < 256; i += 64) { const float r0 = outv[i], o0 = bf2f(O[row * DM + g * 256 + i]); mx = fmaxf(mx, fabsf(r0)); md = fmaxf(md, fabsf(r0 - o0)); }
        for (int off = 1; off < 64; off <<= 1) { mx = fmaxf(mx, shx(mx, off, lane)); md = fmaxf(md, shx(md, off, lane)); }
        if (lane == 0) { unsigned* fl = (unsigned*)(a.ws + WS_FLAG); if (!(md <= 0.03f * mx + 1e-4f)) atomicAdd(fl, 1u); atomicAdd(fl + 1, 1u); }
    }
}
#endif

constexpr size_t WS_BAR = 800 * 1024;
constexpr int LDS_BARST = 159744;
#define XB_TMO      128
#define XB_XCNT(j)  (256  + 64 * (j))
#define XB_XSUB(j)  (1280 + 64 * (j))
#define XB_XGEN(j)  (2304 + 64 * (j))
#define XB_TOP      3328
#define XB_TOPGEN   3392
#define XCD_BAR_WORDS 3456
#define XB_SPIN_CAP (1u << 22)
DI unsigned xb_ld(unsigned* p)              { return __hip_atomic_load(p, __ATOMIC_RELAXED, __HIP_MEMORY_SCOPE_AGENT); }
DI unsigned xb_add(unsigned* p, unsigned v) { return __hip_atomic_fetch_add(p, v, __ATOMIC_RELAXED, __HIP_MEMORY_SCOPE_AGENT); }
DI unsigned xb_xcc_id() { return (unsigned)__builtin_amdgcn_s_getreg((3 << 11) | 20) & 0xFu; }
#define XB_SPIN(cond, bar) do { unsigned _sp = 0; while (cond) { __builtin_amdgcn_s_sleep(1); \
    if ((++_sp & 255u) == 0u) { if (xb_ld(&(bar)[XB_TMO])) break; if (_sp > XB_SPIN_CAP) { atomicAdd(&(bar)[XB_TMO], 1u); break; } } } } while (0)
struct XcdBarrier { unsigned* bar; unsigned x; volatile LAS unsigned* st; };
DI XcdBarrier xcd_barrier_post(unsigned* bar, volatile LAS unsigned* st) {
    XcdBarrier b; b.bar = bar; b.x = xb_xcc_id(); b.st = st;
    if (threadIdx.x == 0) (void)xb_add(&bar[XB_XCNT(b.x)], 1u);
    return b;
}
DI void xcd_barrier_complete(unsigned* bar, unsigned x, unsigned& nloc, unsigned& nx) {
    const unsigned G = gridDim.x * gridDim.y * gridDim.z;
    unsigned sum, cnt, mine, sp = 0u;
    for (;;) {
        sum = 0u; cnt = 0u; mine = 0u;
#pragma unroll
        for (unsigned j = 0; j < 16; ++j) { const unsigned c = xb_ld(&bar[XB_XCNT(j)]); sum += c; cnt += (c > 0u) ? 1u : 0u; mine = (j == x) ? c : mine; }
        if (sum == G) break;
        __builtin_amdgcn_s_sleep(1);
        if ((++sp & 255u) == 0u) { if (xb_ld(&bar[XB_TMO])) break; if (sp > XB_SPIN_CAP) { atomicAdd(&bar[XB_TMO], 1u); break; } }
    }
    nloc = mine > 0u ? mine : 1u; nx = cnt > 0u ? cnt : 1u;
}
DI void xcd_barrier(const XcdBarrier& b) {
    asm volatile("s_waitcnt vmcnt(0)" ::: "memory");
    __syncthreads();
    if (threadIdx.x == 0) {
        unsigned* bar = b.bar;
        __builtin_amdgcn_s_waitcnt(0);
        unsigned nloc = b.st[0], nx = b.st[1];
        if (nloc == 0u) { xcd_barrier_complete(bar, b.x, nloc, nx); b.st[0] = nloc; b.st[1] = nx; }
        const unsigned old = xb_add(&bar[XB_XSUB(b.x)], 1u);
        const unsigned gen = old / nloc;
        if (old + 1u == (gen + 1u) * nloc) {
            __builtin_amdgcn_fence(__ATOMIC_RELEASE, "agent");
            asm volatile("s_waitcnt vmcnt(0)" ::: "memory");
            const unsigned og = xb_add(&bar[XB_TOP], 1u);
            const unsigned tg = og / nx;
            if (og + 1u == (tg + 1u) * nx) xb_add(&bar[XB_TOPGEN], 1u);
            else XB_SPIN(xb_ld(&bar[XB_TOPGEN]) == tg, bar);
            __builtin_amdgcn_fence(__ATOMIC_ACQUIRE, "agent");
            xb_add(&bar[XB_XGEN(b.x)], 1u);
            asm volatile("s_waitcnt vmcnt(0)" ::: "memory");
        } else {
            XB_SPIN(xb_ld(&bar[XB_XGEN(b.x)]) == gen, bar);
            __builtin_amdgcn_fence(__ATOMIC_ACQUIRE, "agent");
            asm volatile("s_waitcnt vmcnt(0)" ::: "memory");
        }
    }
    __syncthreads();
}

enum Op { OP_PRO = 0, OP_NORM, OP_FFN_IN, OP_FFN_OUT, OP_CONV_IN, OP_CONV_EW, OP_CONV_OUT, OP_NSA_IN, OP_NSA_PREP, OP_CMP1, OP_CMP2, OP_ATTN, OP_NSA_OUT };

__global__ void __launch_bounds__(512) mk_fwd(Args a) {
    extern __shared__ __attribute__((aligned(16))) unsigned char lds_raw[];
    LAS unsigned char* lds = (LAS unsigned char*)lds_raw;
    const int G = gridDim.x;
    if (threadIdx.x < 2) ((LAS unsigned*)(lds + LDS_BARST))[threadIdx.x] = 0u;
    __syncthreads();
    const unsigned bar_x = xb_xcc_id();
    if (a.ph_hi - a.ph_lo > 1 && threadIdx.x == 0) (void)xb_add((unsigned*)(a.ws + WS_BAR) + XB_XCNT(bar_x), 1u);

    for (int pi = a.ph_lo; pi < a.ph_hi; ++pi) {
        const int phr = PROG[pi], ph = phr & 63;
#ifdef PROBE_BUILD
        const bool dummy = (phr & 64) != 0;
#else
        constexpr bool dummy = false;
#endif
        int tid = threadIdx.x; asm volatile("" : "+v"(tid));
        const int lane = tid & 63, wid = __builtin_amdgcn_readfirstlane(tid >> 6);
        { size_t z = 0; asm volatile("" : "+s"(z)); a.ws = a.ws0 + z; }
        float* mod = (float*)(a.ws + WS_MOD);
        bf16_t* HB = (bf16_t*)(a.ws + WS_HB); bf16_t* HID = (bf16_t*)(a.ws + WS_HID);
        int op, layer = 0, sub = 0;
        if (ph == 0) op = OP_PRO;
        else if (ph == 63) op = 99;
        else if (ph == 62) op = 98;
        else if (ph == 61) op = 97;
        else {
            int p = ph - 1, s;
            if (p < 10) { layer = 0; s = p; } else if (p < 23) { layer = 1; s = p - 10; } else if (p < 33) { layer = 2; s = p - 23; } else { layer = 3; s = p - 33; }
            if ((layer & 1) == 0) {
                switch (s) { case 0: op = OP_NORM; sub = 0; break; case 1: op = OP_FFN_IN; sub = 0; break; case 2: op = OP_FFN_OUT; sub = 0; break; case 3: op = OP_NORM; sub = 1; break;
                    case 4: op = OP_CONV_IN; break; case 5: op = OP_CONV_EW; break; case 6: op = OP_CONV_OUT; sub = 1; break; case 7: op = OP_NORM; sub = 2; break; case 8: op = OP_FFN_IN; sub = 1; break; default: op = OP_FFN_OUT; sub = 2; break; }
            } else {
                switch (s) { case 0: op = OP_NORM; sub = 0; break; case 1: op = OP_FFN_IN; sub = 0; break; case 2: op = OP_FFN_OUT; sub = 0; break; case 3: op = OP_NORM; sub = 1; break;
                    case 4: op = OP_NSA_IN; break; case 5: op = OP_NSA_PREP; break; case 6: op = OP_CMP1; break; case 7: op = OP_CMP2; break; case 8: op = OP_ATTN; break; case 9: op = OP_NSA_OUT; sub = 1; break;
                    case 10: op = OP_NORM; sub = 2; break; case 11: op = OP_FFN_IN; sub = 1; break; default: op = OP_FFN_OUT; sub = 2; break; }
            }
        }
        const bool fuse = (G == 256);
        if (op == OP_NORM && fuse && !(layer == 0 && sub == 0)) continue;
        const int lj = layer >> 1;
        const float* modL = mod + (size_t)layer * 2 * 9216;
        const bool first = (layer == 0 && (op == OP_NORM || op == OP_FFN_IN || op == OP_FFN_OUT) && sub == 0);
        const float* xsrc = first ? a.x : a.out;

        switch (op) {
#ifndef SKIP_PRO
        case OP_PRO: phase_prologue(a, lds, tid, wid, lane, dummy); break;
#endif
        case OP_NORM: phase_norm(xsrc, a.norm_g + (size_t)(layer * 3 + sub) * DM, modL, sub, HB, wid, lane); break;
        case OP_FFN_IN: {
            const int which = sub;
            pg8::Gemm g{HB, (const bf16_t*)(a.ws + WS_WFI) + (size_t)(layer * 2 + which) * FF2 * DM, DM, DM, 30, 0};
            pg8::StaticOrder S; S.init(TOK, FF2, G, (int)blockIdx.x);
            pg8::EpiSwiGLU E{HID};
            pg8::gemm_phase<pg8::EpiSwiGLU, true>(lds, g, S, E, tid);
        } break;
        case OP_FFN_OUT: case OP_CONV_OUT: case OP_NSA_OUT: {
            pg8::Gemm g;
            if (op == OP_FFN_OUT) g = pg8::Gemm{HID, (const bf16_t*)(a.ws + WS_WFO) + (size_t)(layer * 2 + (sub ? 1 : 0)) * DM * FF, FF, FF, 30, 0};
            else if (op == OP_CONV_OUT) g = pg8::Gemm{HB, (const bf16_t*)(a.ws + WS_WCO) + (size_t)lj * DM * DM, DM, DM, 30, 0};
            else g = pg8::Gemm{HB, (const bf16_t*)(a.ws + WS_WNO) + (size_t)lj * DM * DM, DM, DM, 30, 0};
            pg8::StaticOrder S; S.init(TOK, DM, G, (int)blockIdx.x);
            float* outp = dummy ? (float*)(a.ws + WS_DUMMY) : a.out;
            const float coef = op == OP_FFN_OUT ? 0.5f : 1.0f;
            const bool lastres = (layer == 3 && sub == 2);
            if (fuse && !lastres) {
                const int nl = sub == 2 ? layer + 1 : layer, ns = sub == 2 ? 0 : sub + 1;
                pg8::EpiResNorm E{xsrc, outp, modL + (sub * 3 + 2) * 1024, a.norm_g + (size_t)(nl * 3 + ns) * DM, mod + (size_t)nl * 2 * 9216 + (ns * 3) * 1024,
                                  dummy ? (bf16_t*)(a.ws + WS_DUMMY + 64 * MiB - 34 * MiB) : HB, (float*)(a.ws + WS_XS), (unsigned*)(a.ws + WS_CNT) + (size_t)((layer * 3 + sub) + (dummy ? 12 : 0)) * 64 * 16, coef, 0};
                pg8::gemm_phase<pg8::EpiResNorm, false>(lds, g, S, E, tid);
            } else {
                pg8::EpiRes E{xsrc, outp, modL + (sub * 3 + 2) * 1024, coef};
                pg8::gemm_phase<pg8::EpiRes, false>(lds, g, S, E, tid);
            }
        } break;
        case OP_CONV_IN: {
            pg8::Gemm g{HB, (const bf16_t*)(a.ws + WS_WCI) + (size_t)lj * 3072 * DM, DM, DM, 30, 0};
            pg8::StaticOrder S; S.init(TOK, 3072, G, (int)blockIdx.x);
            pg8::EpiConvIn E{HID, HID + (size_t)TOK * DM};
            pg8::gemm_phase<pg8::EpiConvIn, true>(lds, g, S, E, tid);
        } break;
        case OP_CONV_EW: phase_conv_ew(HID, HID + (size_t)TOK * DM, a.conv_w + (size_t)lj * 3 * DM, HB, tid); break;
        case OP_NSA_IN: {
            pg8::Gemm g{HB, (const bf16_t*)(a.ws + WS_WNI) + (size_t)lj * NSA_P * DM, DM, DM, 30, 0};
            pg8::StaticOrder S; S.init(TOK, NSA_P, G, (int)blockIdx.x);
            pg8::EpiPlain E{HID, NSA_P};
            pg8::gemm_phase<pg8::EpiPlain, true>(lds, g, S, E, tid);
        } break;
#ifndef SKIP_PREP
        case OP_NSA_PREP: phase_nsa_prep(a, lj, lds, tid); break;
#endif
        case OP_CMP1: {
            pg8::Gemm g{(const bf16_t*)(a.ws + WS_KCT), (const bf16_t*)(a.ws + WS_WC1) + (size_t)lj * 2 * 512 * 1024, 1024, 1024, 4, (size_t)512 * 1024};
            pg8::StaticOrder S; S.init(8192, 512, G, (int)blockIdx.x);
            pg8::EpiCmp E{(float*)(a.ws + WS_Y1)};
            pg8::gemm_phase<pg8::EpiCmp, false>(lds, g, S, E, tid);
        } break;
        case OP_CMP2: phase_cmp2(a, lj, lds, tid, wid, lane); break;
#ifndef SKIP_ATTN
        case OP_ATTN: phase_attn(a, lds, tid, wid, lane); break;
#endif
#ifdef SELFTEST
        case 98: phase_selftest(a, lds, wid, lane); break;
        case 97: { const unsigned* fl = (const unsigned*)(a.ws + WS_FLAG); const unsigned bad = __hip_atomic_load(fl, __ATOMIC_RELAXED, __HIP_MEMORY_SCOPE_AGENT), tot = __hip_atomic_load(fl + 1, __ATOMIC_RELAXED, __HIP_MEMORY_SCOPE_AGENT);
                   if (blockIdx.x == 0 && (tot != 2u * 8u * 144u || bad * SELFTEST > tot)) a.out[tid] = __builtin_nanf(""); } break;
#endif
        default: break;
        }
        if (pi + 1 < a.ph_hi) {
            if (pi == a.ph_lo) { __syncthreads(); cg::this_grid().sync(); }
            else { XcdBarrier xb; xb.bar = (unsigned*)(a.ws + WS_BAR); xb.x = bar_x; xb.st = (volatile LAS unsigned*)(lds + LDS_BARST); xcd_barrier(xb); }
        }
    }
}

extern "C" void kernel_launch(void* const* d_in, const int* in_sizes, int n_in, void* d_out, int out_size, void* d_ws, size_t ws_size, hipStream_t stream) {
    static int grid = 0;
    if (grid == 0) {
        int dev = 0, cus = 0, per_cu = 0;
        if (n_in != 18 || ws_size < WS_END) { fprintf(stderr, "kernel_launch: unexpected n_in %d / ws %zu\n", n_in, ws_size); grid = -1; return; }
        hipGetDevice(&dev);
        hipDeviceGetAttribute(&cus, hipDeviceAttributeMultiprocessorCount, dev);
        hipFuncSetAttribute((const void*)mk_fwd, hipFuncAttributeMaxDynamicSharedMemorySize, LDS_BYTES);
        hipOccupancyMaxActiveBlocksPerMultiprocessor(&per_cu, (const void*)mk_fwd, 512, LDS_BYTES);
        if (per_cu < 1) per_cu = 1;
        grid = cus * per_cu;
        (void)hipGetLastError();
    }
    if (grid < 0) return;
    hipMemsetAsync(d_ws, 0, WS_ZERO_BYTES, stream);
    Args a{};
    a.x = (const float*)d_in[0]; a.c = (const float*)d_in[1]; a.norm_g = (const float*)d_in[2]; a.ada_w = (const float*)d_in[3]; a.ada_b = (const float*)d_in[4];
    a.ffn_w_in = (const float*)d_in[5]; a.ffn_w_out = (const float*)d_in[6]; a.conv_w_in = (const float*)d_in[7]; a.conv_w = (const float*)d_in[8]; a.conv_w_out = (const float*)d_in[9];
    a.nsa_w_in = (const float*)d_in[10]; a.cmp_pos = (const float*)d_in[11]; a.cmp_w1 = (const float*)d_in[12]; a.cmp_w2 = (const float*)d_in[13];
    a.q_gain = (const float*)d_in[14]; a.k_gain = (const float*)d_in[15]; a.nsa_w_out = (const float*)d_in[16]; a.rel_bias = (const float*)d_in[17];
    a.out = (float*)d_out; a.ws = (unsigned char*)d_ws; a.ws0 = (unsigned char*)d_ws;
#if MK_MULTI
    for (int ph = 0; ph < NPH; ++ph) { a.ph_lo = ph; a.ph_hi = ph + 1; hipLaunchKernelGGL(mk_fwd, dim3(grid), dim3(512), LDS_BYTES, stream, a); }
#else
    a.ph_lo = 0; a.ph_hi = NPH;
    void* args[] = {&a};
    hipError_t e = hipLaunchCooperativeKernel((const void*)mk_fwd, dim3(grid), dim3(512), args, LDS_BYTES, stream);
    if (e != hipSuccess) fprintf(stderr, "cooperative launch failed: %s (grid %d)\n", hipGetErrorString(e), grid);
#endif
}
```

```cpp
#include <hip/hip_runtime.h>
#include <hip/hip_cooperative_groups.h>
#include <cstdint>
#include <cstdio>
namespace cg = cooperative_groups;

#ifndef MK_MULTI
#define MK_MULTI 0
#endif

#define DI __device__ __forceinline__
#define LAS __attribute__((address_space(3)))
typedef unsigned short bf16_t;
typedef short bf16x8 __attribute__((ext_vector_type(8)));
typedef float f32x4 __attribute__((ext_vector_type(4)));
typedef float f32x2 __attribute__((ext_vector_type(2)));
typedef unsigned u32x4 __attribute__((ext_vector_type(4)));
typedef unsigned u32x2 __attribute__((ext_vector_type(2)));
typedef __bf16 bf16x2_t __attribute__((ext_vector_type(2)));

constexpr int SEQ = 8192, TOK = 16384, DM = 1024, FF = 2816, FF2 = 5632;
constexpr int NSA_IN = 2608, NSA_P = 2816;
constexpr float RMS_EPS = 1e-6f;
__constant__ unsigned char PROG[] = {0,1,2,3,4,5,6,7,8,9,10,11,12,13,14,15,16,17,18,19,20,21,22,23,24,25,26,27,28,29,30,31,32,33,34,35,36,37,38,39,40,41,42,43,44,45,46};
constexpr int NPH = 47;

constexpr size_t MiB = 1u << 20;
constexpr size_t WS_MOD = 0;
constexpr size_t WS_BIAS1 = 512 * 1024;
constexpr size_t WS_ZERO_BYTES = 1 * MiB;
constexpr size_t WS_WFI = 2 * MiB;
constexpr size_t WS_WFO = 90 * MiB;
constexpr size_t WS_WCI = 134 * MiB;
constexpr size_t WS_WCO = 146 * MiB;
constexpr size_t WS_WNI = 150 * MiB;
constexpr size_t WS_WNO = 161 * MiB;
constexpr size_t WS_WC1 = 165 * MiB;
constexpr size_t WS_HB = 170 * MiB;
constexpr size_t WS_HID = 202 * MiB;
constexpr size_t WS_QN = 290 * MiB;
constexpr size_t WS_KCT = 322 * MiB;
constexpr size_t WS_KSEL = 339 * MiB;
constexpr size_t WS_KWIN = 347 * MiB;
constexpr size_t WS_VSELT = 355 * MiB;
constexpr size_t WS_VWINT = 363 * MiB;
constexpr size_t WS_H1 = 371 * MiB;
constexpr size_t WS_KCMP = 379 * MiB;
constexpr size_t WS_VCMPT = 380 * MiB;
constexpr size_t WS_GATES = 381 * MiB;
constexpr size_t WS_DUMMY = 384 * MiB;
constexpr size_t WS_XS = 448 * MiB;
constexpr size_t WS_CNT = 300 * 1024;
constexpr size_t WS_Y1 = 450 * MiB;
constexpr size_t WS_END = 466 * MiB;

constexpr int LDS_BYTES = 163840;

DI unsigned pk2(float lo, float hi) { f32x2 v = {lo, hi}; bf16x2_t b = __builtin_convertvector(v, bf16x2_t); return __builtin_bit_cast(unsigned, b); }
DI float lo_f(unsigned w) { return __uint_as_float(w << 16); }
DI float hi_f(unsigned w) { return __uint_as_float(w & 0xffff0000u); }
DI float bf2f(bf16_t h) { return __uint_as_float((unsigned)h << 16); }
DI float shx(float v, int off, int lane) { return __int_as_float(__builtin_amdgcn_ds_bpermute((lane ^ off) << 2, __float_as_int(v))); }
DI int shxi(int v, int off, int lane) { return __builtin_amdgcn_ds_bpermute((lane ^ off) << 2, v); }
DI float wave_sum(float v, int lane) {
#pragma unroll
    for (int o = 1; o < 64; o <<= 1) v += shx(v, o, lane);
    return v;
}
DI float sigmoidf_(float x) { return 1.0f / (1.0f + __expf(-x)); }

namespace pg8 {
constexpr int BM = 256, BK = 64, HALF = 128, HTB = HALF * BK * 2, STAGE_BYTES = 8 * HTB, NXCD = 8, WGM = 8;
__host__ __device__ __forceinline__ int lds_byte(int r, int c) { const int st = (r >> 4) * 2 + (c >> 5), rr = r & 15, cc = c & 31, ob = rr * 64 + cc * 2; return st * 1024 + (ob ^ (((ob >> 9) & 1) << 5)); }
__host__ __device__ __forceinline__ void stage_rc(int b, int& R, int& C) { const int st = b / 1024, sb = b % 1024, swz = sb ^ (((sb >> 9) & 1) << 5); R = (st >> 1) * 16 + swz / 64; C = (st & 1) * 32 + (swz % 64) / 2; }
__host__ __device__ __forceinline__ int perm32(int rho) { const int n = rho >> 4, i = rho & 15; return 8 * (i >> 2) + 4 * n + (i & 3); }

struct Unit { int pm, pn; };
struct Gemm { const bf16_t* A; const bf16_t* Bt; int lda, K; int bshift; size_t bstride; };

struct StaticOrder {
    int nM, nN, nwg, G, c;
    __device__ void init(int M, int N, int G_, int c_) { nM = M / BM; nN = N / BM; nwg = nM * nN; G = G_; c = c_; }
    __device__ bool next(int i, Unit& u) const {
        const long L = (long)i * G + c; if (L >= nwg) return false;
        int wgid = (int)L; { const int q = nwg / NXCD, r = nwg % NXCD, xcd = wgid % NXCD, off = wgid / NXCD; wgid = (xcd < r ? xcd * (q + 1) : r * (q + 1) + (xcd - r) * q) + off; }
        const int nig = WGM * nN, gid = wgid / nig, fm = gid * WGM, gsz = (nM - fm) < WGM ? (nM - fm) : WGM;
        u.pm = fm + ((wgid % nig) % gsz); u.pn = (wgid % nig) / gsz; return true;
    }
};

struct EpiSwiGLU {
    static constexpr bool PERM = true, AFTER_DRAIN = false;
    bf16_t* O;
    DI void operator()(const f32x4 (&acc)[2][2][4][2], const Unit& u, int wr, int wc, int fr, int fq) const {
        const int row0 = u.pm * BM + wr * 64 + fr, col0 = u.pn * 128 + wc * 32 + 8 * fq;
#pragma unroll
        for (int ai = 0; ai < 2; ++ai)
#pragma unroll
            for (int m = 0; m < 4; ++m) {
                bf16_t* rowp = O + (size_t)(row0 + ai * HALF + m * 16) * FF + col0;
                float v[8];
#pragma unroll
                for (int n = 0; n < 2; ++n)
#pragma unroll
                    for (int j = 0; j < 4; ++j) { const float g = acc[ai][0][m][n][j], up = acc[ai][1][m][n][j]; v[n * 4 + j] = g * up * __builtin_amdgcn_rcpf(1.0f + __expf(-g)); }
                u32x4 w; w.x = pk2(v[0], v[1]); w.y = pk2(v[2], v[3]); w.z = pk2(v[4], v[5]); w.w = pk2(v[6], v[7]);
                *(u32x4*)rowp = w;
            }
    }
};
struct EpiRes {
    static constexpr bool PERM = false, AFTER_DRAIN = false;
    const float* base; float* out; const float* gate; float coef;
    DI void operator()(const f32x4 (&acc)[2][2][4][2], const Unit& u, int wr, int wc, int fr, int fq) const {
        const int row0 = u.pm * BM + wr * 64 + fr, col0 = u.pn * BM + wc * 32 + 4 * fq, b = u.pm >> 5;
        f32x4 gv[2][2];
#pragma unroll
        for (int bj = 0; bj < 2; ++bj)
#pragma unroll
            for (int n = 0; n < 2; ++n) gv[bj][n] = *(const f32x4*)(gate + b * 9216 + col0 + bj * HALF + n * 16) * coef;
#pragma unroll
        for (int ai = 0; ai < 2; ++ai)
#pragma unroll
            for (int m = 0; m < 4; ++m) {
                const size_t off = (size_t)(row0 + ai * HALF + m * 16) * DM + col0;
#pragma unroll
                for (int bj = 0; bj < 2; ++bj)
#pragma unroll
                    for (int n = 0; n < 2; ++n) { const f32x4 bs = *(const f32x4*)(base + off + bj * HALF + n * 16); *(f32x4*)(out + off + bj * HALF + n * 16) = bs + gv[bj][n] * acc[ai][bj][m][n]; }
                if (m & 1) asm volatile("" ::: "memory");
            }
    }
};
struct EpiConvIn {
    static constexpr bool PERM = true, AFTER_DRAIN = false;
    bf16_t* U; bf16_t* Bg;
    DI void operator()(const f32x4 (&acc)[2][2][4][2], const Unit& u, int wr, int wc, int fr, int fq) const {
        const int row0 = u.pm * BM + wr * 64 + fr;
        if (u.pn < 8) {
            const int col0 = u.pn * 128 + wc * 32 + 8 * fq;
#pragma unroll
            for (int ai = 0; ai < 2; ++ai)
#pragma unroll
                for (int m = 0; m < 4; ++m) {
                    const f32x4 a = acc[ai][0][m][0] * acc[ai][1][m][0], c = acc[ai][0][m][1] * acc[ai][1][m][1];
                    u32x4 w; w.x = pk2(a[0], a[1]); w.y = pk2(a[2], a[3]); w.z = pk2(c[0], c[1]); w.w = pk2(c[2], c[3]);
                    *(u32x4*)(U + (size_t)(row0 + ai * HALF + m * 16) * DM + col0) = w;
                }
        } else {
            const int col0 = (u.pn - 8) * BM + wc * 32 + 8 * fq;
#pragma unroll
            for (int ai = 0; ai < 2; ++ai)
#pragma unroll
                for (int m = 0; m < 4; ++m)
#pragma unroll
                    for (int bj = 0; bj < 2; ++bj) {
                        const f32x4 a = acc[ai][bj][m][0], c = acc[ai][bj][m][1];
                        u32x4 w; w.x = pk2(a[0], a[1]); w.y = pk2(a[2], a[3]); w.z = pk2(c[0], c[1]); w.w = pk2(c[2], c[3]);
                        *(u32x4*)(Bg + (size_t)(row0 + ai * HALF + m * 16) * DM + col0 + bj * HALF) = w;
                    }
        }
    }
};
struct EpiPlain {
    static constexpr bool PERM = true, AFTER_DRAIN = false;
    bf16_t* O; int ldc;
    DI void operator()(const f32x4 (&acc)[2][2][4][2], const Unit& u, int wr, int wc, int fr, int fq) const {
        const int row0 = u.pm * BM + wr * 64 + fr, col0 = u.pn * BM + wc * 32 + 8 * fq;
#pragma unroll
        for (int ai = 0; ai < 2; ++ai)
#pragma unroll
            for (int m = 0; m < 4; ++m)
#pragma unroll
                for (int bj = 0; bj < 2; ++bj) {
                    const f32x4 a = acc[ai][bj][m][0], c = acc[ai][bj][m][1];
                    u32x4 w; w.x = pk2(a[0], a[1]); w.y = pk2(a[2], a[3]); w.z = pk2(c[0], c[1]); w.w = pk2(c[2], c[3]);
                    *(u32x4*)(O + (size_t)(row0 + ai * HALF + m * 16) * ldc + col0 + bj * HALF) = w;
                }
    }
};
struct EpiCmp {
    static constexpr bool PERM = false, AFTER_DRAIN = false;
    float* Y;
    DI void operator()(const f32x4 (&acc)[2][2][4][2], const Unit& u, int wr, int wc, int fr, int fq) const {
        const int row0 = u.pm * BM + wr * 64 + fr, col0 = u.pn * BM + wc * 32 + 4 * fq;
#pragma unroll
        for (int ai = 0; ai < 2; ++ai)
#pragma unroll
            for (int m = 0; m < 4; ++m)
#pragma unroll
                for (int bj = 0; bj < 2; ++bj)
#pragma unroll
                    for (int n = 0; n < 2; ++n) *(f32x4*)(Y + (size_t)(row0 + ai * HALF + m * 16) * 512 + col0 + bj * HALF + n * 16) = acc[ai][bj][m][n];
    }
};
struct EpiResNorm {
    static constexpr bool PERM = false, AFTER_DRAIN = true;
    const float* base; float* out; const float* gate;
    const float* ng; const float* nshift; bf16_t* H; float* xs; unsigned* cnt; float coef; int pad;
    DI void fused(f32x4 (&acc)[2][2][4][2], const Unit& u, int wr, int wc, int fr, int fq, LAS unsigned char* lds, int wid, int lane, int tid) const {
        const int row0 = u.pm * BM + wr * 64 + fr, col0 = u.pn * BM + wc * 32 + 4 * fq, b = u.pm >> 5;
        LAS float* P = (LAS float*)lds; LAS float* R = (LAS float*)(lds + 4096);
        {
            f32x4 gv[2][2];
#pragma unroll
            for (int bj = 0; bj < 2; ++bj)
#pragma unroll
                for (int n = 0; n < 2; ++n) gv[bj][n] = *(const f32x4*)(gate + b * 9216 + col0 + bj * HALF + n * 16) * coef;
#pragma unroll
            for (int ai = 0; ai < 2; ++ai)
#pragma unroll
                for (int m = 0; m < 4; ++m) {
                    const size_t off = (size_t)(row0 + ai * HALF + m * 16) * DM + col0; float sq = 0.f;
#pragma unroll
                    for (int bj = 0; bj < 2; ++bj)
#pragma unroll
                        for (int n = 0; n < 2; ++n) { const f32x4 bs = *(const f32x4*)(base + off + bj * HALF + n * 16); const f32x4 x = bs + gv[bj][n] * acc[ai][bj][m][n];
                            acc[ai][bj][m][n] = x; *(f32x4*)(out + off + bj * HALF + n * 16) = x; sq += (x[0] * x[0] + x[1] * x[1]) + (x[2] * x[2] + x[3] * x[3]); }
                    sq += shx(sq, 16, lane); sq += shx(sq, 32, lane);
                    if (fq == 0) P[(ai * HALF + wr * 64 + m * 16 + fr) * 4 + wc] = sq;
                    if (m & 1) asm volatile("" ::: "memory");
                }
        }
        __syncthreads();
        if (tid < 256) { const float tot = (P[tid * 4 + 0] + P[tid * 4 + 1]) + (P[tid * 4 + 2] + P[tid * 4 + 3]);
            __hip_atomic_store(xs + (size_t)(u.pm * BM + tid) * 4 + u.pn, tot, __ATOMIC_RELAXED, __HIP_MEMORY_SCOPE_AGENT); }
        asm volatile("s_waitcnt vmcnt(0)" ::: "memory");
        if (tid < 256 && lane == 0) __hip_atomic_fetch_add(cnt + 16 * u.pm, 1u, __ATOMIC_RELAXED, __HIP_MEMORY_SCOPE_AGENT);
        if (wid == 0) {
            unsigned sp = 0;
            while ((unsigned)__builtin_amdgcn_readfirstlane(__hip_atomic_load(cnt + 16 * u.pm, __ATOMIC_RELAXED, __HIP_MEMORY_SCOPE_AGENT)) < 16u) { __builtin_amdgcn_s_sleep(2); if (++sp > (1u << 22)) break; }
            __builtin_amdgcn_fence(__ATOMIC_ACQUIRE, "agent");
        }
        asm volatile("s_waitcnt vmcnt(0) lgkmcnt(0)" ::: "memory");
        __syncthreads();
        if (tid < 256) { const float* sl = xs + (size_t)(u.pm * BM + tid) * 4; float t = 0.f;
#pragma unroll
            for (int k = 0; k < 4; ++k) t += __hip_atomic_load(sl + k, __ATOMIC_RELAXED, __HIP_MEMORY_SCOPE_AGENT);
            R[tid] = rsqrtf(t * (1.f / DM) + RMS_EPS); }
        __syncthreads();
        const float* nsc = nshift + 1024;
#pragma unroll
        for (int bj = 0; bj < 2; ++bj)
#pragma unroll
            for (int n = 0; n < 2; ++n) {
                const int col = col0 + bj * HALF + n * 16;
                const f32x4 gg = *(const f32x4*)(ng + col), sc = *(const f32x4*)(nsc + b * 9216 + col), sh = *(const f32x4*)(nshift + b * 9216 + col);
                const f32x4 w = gg * (sc + 1.0f);
#pragma unroll
                for (int ai = 0; ai < 2; ++ai)
#pragma unroll
                    for (int m = 0; m < 4; ++m) {
                        const int rl = ai * HALF + wr * 64 + m * 16 + fr; const float r = R[rl];
                        const f32x4 y = acc[ai][bj][m][n] * r * w + sh;
                        u32x2 o; o.x = pk2(y[0], y[1]); o.y = pk2(y[2], y[3]);
                        *(u32x2*)(H + (size_t)(u.pm * BM + rl) * DM + col) = o;
                    }
            }
    }
};

template <class Epi, bool ALIGN_EPI>
__device__ __forceinline__ void gemm_phase(LAS unsigned char* lds, const Gemm& g, const StaticOrder& S, const Epi& E, const int tid) {
    const int wid = __builtin_amdgcn_readfirstlane(tid >> 6), lane = tid & 63, wr = wid >> 2, wc = wid & 3, fr = lane & 15, fq = lane >> 4;
    const int K = g.K, lda = g.lda, nt = K / BK;
    unsigned voffA[2], voffB[2];
#pragma unroll
    for (int i = 0; i < 2; ++i) { int R, C; stage_rc(tid * 16 + i * 8192, R, C); const int Rb = Epi::PERM ? ((R & ~31) + perm32(R & 31)) : R;
        voffA[i] = (unsigned)(R * lda + C) * 2u; voffB[i] = (unsigned)(Rb * K + C) * 2u; }
    const size_t kstep = (size_t)(BK * 2);
    const size_t hstepA = (size_t)HALF * lda * 2, hstepB = (size_t)HALF * K * 2;
    const size_t tstepA = 2 * hstepA, tstepB = 2 * hstepB;
    const unsigned ldsw = (unsigned)wid * 1024u;
    const int aoff = lds_byte(wr * 64 + fr, fq * 8), boff = lds_byte(wc * 32 + fr, fq * 8);
#define PG8_SA(b, h) (((b) * 2 + (h)) * HTB)
#define PG8_SB(b, h) ((4 + (b) * 2 + (h)) * HTB)
#define PG8_STAGE(bufoff, gbase, voff) do { _Pragma("unroll") for (int _i = 0; _i < 2; ++_i) \
        __builtin_amdgcn_global_load_lds((const unsigned*)((const char*)(gbase) + (voff)[_i]), (LAS unsigned*)(lds + (bufoff) + ldsw + _i * 8192), 16, 0, 0); } while (0)
#define PG8_LDA(dst, b, h) do { _Pragma("unroll") for (int m = 0; m < 4; ++m) _Pragma("unroll") for (int k = 0; k < 2; ++k) dst[m][k] = *(const LAS bf16x8*)(lds + PG8_SA(b, h) + aoff + m * 2048 + k * 1024); } while (0)
#define PG8_LDB(dst, b, h) do { _Pragma("unroll") for (int n = 0; n < 2; ++n) _Pragma("unroll") for (int k = 0; k < 2; ++k) dst[n][k] = *(const LAS bf16x8*)(lds + PG8_SB(b, h) + boff + n * 2048 + k * 1024); } while (0)
#define PG8_MMA(ai, bj, At, Bt) do { __builtin_amdgcn_s_setprio(1); _Pragma("unroll") for (int m = 0; m < 4; ++m) _Pragma("unroll") for (int n = 0; n < 2; ++n) _Pragma("unroll") for (int k = 0; k < 2; ++k) \
        acc[ai][bj][m][n] = __builtin_amdgcn_mfma_f32_16x16x32_bf16(Bt[n][k], At[m][k], acc[ai][bj][m][n], 0, 0, 0); __builtin_amdgcn_s_setprio(0); } while (0)
#define PG8_WAIT_V(n) asm volatile("s_waitcnt vmcnt(" #n ")" ::: "memory")
#define PG8_WAIT_L(n) asm volatile("s_waitcnt lgkmcnt(" #n ")" ::: "memory")
#define PG8_BAR __builtin_amdgcn_s_barrier()
#define PG8_SCHED __builtin_amdgcn_sched_barrier(0)
#define PG8_ABASE(u) ((const char*)g.A + (size_t)(u).pm * tstepA)
#define PG8_BBASE(u) ((const char*)g.Bt + (size_t)(u).pn * tstepB + (size_t)((u).pm >> g.bshift) * g.bstride * 2)
    Unit cur, nxt; int ui = 0;
    if (!S.next(0, cur)) return;
    f32x4 acc[2][2][4][2];
#pragma unroll
    for (int a = 0; a < 2; ++a)
#pragma unroll
        for (int b = 0; b < 2; ++b)
#pragma unroll
            for (int m = 0; m < 4; ++m)
#pragma unroll
                for (int n = 0; n < 2; ++n) acc[a][b][m][n] = (f32x4){0.f, 0.f, 0.f, 0.f};
    bf16x8 At[4][2], B0[2][2], B1[2][2];
    const char* cA = PG8_ABASE(cur); const char* cB = PG8_BBASE(cur);
    PG8_STAGE(PG8_SB(0, 0), cB, voffB); PG8_STAGE(PG8_SB(0, 1), cB + hstepB, voffB); PG8_STAGE(PG8_SA(0, 0), cA, voffA); PG8_STAGE(PG8_SA(0, 1), cA + hstepA, voffA);
    if (wr == 1) PG8_BAR;
    PG8_WAIT_V(2); PG8_BAR;
    PG8_STAGE(PG8_SB(1, 0), cB + kstep, voffB); PG8_STAGE(PG8_SA(1, 0), cA + kstep, voffA); PG8_STAGE(PG8_SB(1, 1), cB + hstepB + kstep, voffB);
    PG8_WAIT_V(6); PG8_BAR;
    for (;;) {
        const bool has_next = S.next(ui + 1, nxt);
        const char* nA = has_next ? PG8_ABASE(nxt) : cA; const char* nB = has_next ? PG8_BBASE(nxt) : cB;
        for (int t = 0; t < nt; t += 2) {
            const bool last = (t == nt - 2);
            const char* a1 = cA + (size_t)(t + 1) * kstep;
            const char* a2 = last ? nA : cA + (size_t)(t + 2) * kstep; const char* b2 = last ? nB : cB + (size_t)(t + 2) * kstep;
            const char* a3 = a2 + kstep; const char* b3 = b2 + kstep;
            PG8_LDB(B0, 0, 0); PG8_LDB(B1, 0, 1); PG8_SCHED; PG8_LDA(At, 0, 0); PG8_STAGE(PG8_SA(1, 1), a1 + hstepA, voffA);
            PG8_WAIT_V(8); PG8_WAIT_L(0); PG8_BAR; PG8_MMA(0, 0, At, B0); PG8_MMA(0, 1, At, B1); PG8_BAR; PG8_SCHED;
            PG8_LDA(At, 0, 1); PG8_STAGE(PG8_SB(0, 0), b2, voffB); PG8_STAGE(PG8_SB(0, 1), b2 + hstepB, voffB); PG8_STAGE(PG8_SA(0, 0), a2, voffA);
            PG8_WAIT_V(8); PG8_WAIT_L(0); PG8_BAR; PG8_MMA(1, 0, At, B0); PG8_MMA(1, 1, At, B1); PG8_BAR; PG8_SCHED;
            PG8_LDB(B0, 1, 0); PG8_LDB(B1, 1, 1); PG8_SCHED; PG8_LDA(At, 1, 0); PG8_STAGE(PG8_SA(0, 1), a2 + hstepA, voffA);
            PG8_WAIT_V(8); PG8_WAIT_L(0); PG8_BAR; PG8_MMA(0, 0, At, B0); PG8_MMA(0, 1, At, B1); PG8_BAR; PG8_SCHED;
            PG8_LDA(At, 1, 1); PG8_STAGE(PG8_SB(1, 0), b3, voffB); PG8_STAGE(PG8_SB(1, 1), b3 + hstepB, voffB); PG8_STAGE(PG8_SA(1, 0), a3, voffA);
            PG8_WAIT_V(8); PG8_WAIT_L(0); PG8_BAR; PG8_MMA(1, 0, At, B0); PG8_MMA(1, 1, At, B1); PG8_BAR; PG8_SCHED;
        }
        if constexpr (ALIGN_EPI) { if (wr == 0) PG8_BAR; }
        if constexpr (!Epi::AFTER_DRAIN) E(acc, cur, wr, wc, fr, fq);
        if (!has_next) break;
#pragma unroll
        for (int a = 0; a < 2; ++a)
#pragma unroll
            for (int b = 0; b < 2; ++b)
#pragma unroll
                for (int m = 0; m < 4; ++m)
#pragma unroll
                    for (int n = 0; n < 2; ++n) acc[a][b][m][n] = (f32x4){0.f, 0.f, 0.f, 0.f};
        cur = nxt; cA = nA; cB = nB; ++ui;
        if constexpr (ALIGN_EPI) { if (wr == 1) PG8_BAR; }
    }
    PG8_WAIT_V(0);
    if constexpr (!ALIGN_EPI) { if (wr == 0) PG8_BAR; }
    PG8_BAR;
    if constexpr (Epi::AFTER_DRAIN) E.fused(acc, cur, wr, wc, fr, fq, lds, wid, lane, tid);
#undef PG8_SA
#undef PG8_SB
#undef PG8_STAGE
#undef PG8_LDA
#undef PG8_LDB
#undef PG8_MMA
#undef PG8_WAIT_V
#undef PG8_WAIT_L
#undef PG8_BAR
#undef PG8_SCHED
#undef PG8_ABASE
#undef PG8_BBASE
}
}

struct Args {
    const float* x; const float* c; const float* norm_g; const float* ada_w; const float* ada_b; const float* ffn_w_in; const float* ffn_w_out;
    const float* conv_w_in; const float* conv_w; const float* conv_w_out; const float* nsa_w_in; const float* cmp_pos; const float* cmp_w1; const float* cmp_w2;
    const float* q_gain; const float* k_gain; const float* nsa_w_out; const float* rel_bias;
    float* out; unsigned char* ws; unsigned char* ws0; int ph_lo, ph_hi;
};

DI int dest_row(int mode, int n) {
    if (mode == 0) return n;
    if (mode == 1) { const int hi = n >= FF, j = hi ? n - FF : n; return (j >> 7) * 256 + hi * 128 + (j & 127); }
    if (n < 1024) return 2048 + n;
    const int hi = n >= 2048, j = n - 1024 - hi * 1024; return (j >> 7) * 256 + hi * 128 + (j & 127);
}
struct TrItem { const float* W; bf16_t* WT; int K, N, k0, n0, mode; };
DI void tr_load(const TrItem& t, f32x4 (&v)[8], int tid) {
    const int n = t.n0 + (tid & 63) * 4, kr = tid >> 6;
#pragma unroll
    for (int i = 0; i < 8; ++i) v[i] = (n < t.N) ? __builtin_nontemporal_load((const f32x4*)(t.W + (size_t)(t.k0 + kr + 8 * i) * t.N + n)) : (f32x4){0.f, 0.f, 0.f, 0.f};
}
DI void tr_to_lds(LAS float* tile, const f32x4 (&v)[8], int tid) {
    const int nn = (tid & 63) * 4, kr = tid >> 6;
#pragma unroll
    for (int i = 0; i < 8; ++i) { LAS float* p = tile + (kr + 8 * i) * 257 + nn; p[0] = v[i].x; p[1] = v[i].y; p[2] = v[i].z; p[3] = v[i].w; }
}
DI void tr_store(const TrItem& t, const LAS float* tile, int tid) {
#pragma unroll
    for (int j = 0; j < 4; ++j) { const int id = tid + 512 * j, kc = id & 7, n = id >> 3;
        const LAS float* s = tile + (kc * 8) * 257 + n;
        u32x4 o; o.x = pk2(s[0 * 257], s[1 * 257]); o.y = pk2(s[2 * 257], s[3 * 257]); o.z = pk2(s[4 * 257], s[5 * 257]); o.w = pk2(s[6 * 257], s[7 * 257]);
        if (t.mode == 3) *(u32x4*)(t.WT + (size_t)(t.n0 + n + ((t.k0 >> 10) << 8)) * 1024 + (t.k0 & 1023) + kc * 8) = o;
        else *(u32x4*)(t.WT + (size_t)dest_row(t.mode, t.n0 + n) * t.K + t.k0 + kc * 8) = o; }
}
DI void tr_kind(const float* W, bf16_t* WT, int nmtx, int K, int N, int NP, int mode, int cum, LAS float* tile, int tid) {
    const int nkb = K / 64, nnb = NP / 256, per = nkb * nnb, total = nmtx * per, G = gridDim.x;
    int it = ((int)blockIdx.x - cum % G + G) % G;
    f32x4 v[8];
    TrItem t; t.K = K; t.N = N; t.mode = mode;
    if (it < total) { const int mtx = it / per, q = it % per; t.W = W + (size_t)mtx * K * N; t.WT = WT + (size_t)mtx * NP * K; t.k0 = (q / nnb) * 64; t.n0 = (q % nnb) * 256; tr_load(t, v, tid); }
    for (; it < total; it += G) {
        tr_to_lds(tile, v, tid);
        __syncthreads();
        const TrItem tc = t;
        const int nx = it + G;
        if (nx < total) { const int mtx = nx / per, q = nx % per; t.W = W + (size_t)mtx * K * N; t.WT = WT + (size_t)mtx * NP * K; t.k0 = (q / nnb) * 64; t.n0 = (q % nnb) * 256; tr_load(t, v, tid); }
        tr_store(tc, tile, tid);
        __syncthreads();
    }
}

DI void phase_prologue(const Args& a, LAS unsigned char* lds, int tid, int wid, int lane, bool dummy) {
    float* mod = (float*)(a.ws + (dummy ? WS_DUMMY : WS_MOD)); float* bias1 = (float*)(a.ws + (dummy ? WS_DUMMY + 2 * MiB : WS_BIAS1));
    for (int it = blockIdx.x; it < 576 + 32; it += gridDim.x) {
        if (it < 576) {
            const int i = it / 144, r = it % 144, kc = r / 9, jb = r % 9;
            const int col = jb * 1024 + (tid & 255) * 4, kh = tid >> 8, kbeg = kc * 64 + kh * 32;
            f32x4 s0 = {0.f, 0.f, 0.f, 0.f}, s1 = {0.f, 0.f, 0.f, 0.f};
            const float* wp = a.ada_w + ((size_t)i * 1024 + kbeg) * 9216 + col;
#pragma unroll 8
            for (int k = 0; k < 32; ++k) {
                const f32x4 w = __builtin_nontemporal_load((const f32x4*)(wp + (size_t)k * 9216));
                const float c0 = a.c[kbeg + k], c1 = a.c[1024 + kbeg + k];
                s0 += w * (c0 * sigmoidf_(c0)); s1 += w * (c1 * sigmoidf_(c1));
            }
            if (kc == 0 && kh == 0) { const f32x4 bb = *(const f32x4*)(a.ada_b + i * 9216 + col); s0 += bb; s1 += bb; }
            float* m0 = mod + (size_t)(i * 2 + 0) * 9216 + col; float* m1 = mod + (size_t)(i * 2 + 1) * 9216 + col;
#pragma unroll
            for (int e = 0; e < 4; ++e) { atomicAdd(m0 + e, s0[e]); atomicAdd(m1 + e, s1[e]); }
        } else if (tid < 256) {
            const int r = it - 576, lk = r >> 3, part = r & 7, l = lk >> 1;
            const float* pos = a.cmp_pos + (size_t)l * 2048 + part * 256;
            const float* w = a.cmp_w1 + ((size_t)lk * 2048 + part * 256) * 256 + tid;
            float s = 0.f;
#pragma unroll 8
            for (int k = 0; k < 256; ++k) s += pos[k] * w[(size_t)k * 256];
            atomicAdd(bias1 + lk * 256 + tid, s);
        }
    }
    {
        LAS float* tile = (LAS float*)lds;
        constexpr int C0 = 0, C1 = C0 + 8 * 16 * 22, C2 = C1 + 8 * 44 * 4, C3 = C2 + 2 * 16 * 12, C4 = C3 + 2 * 16 * 4, C5 = C4 + 2 * 16 * 11, C6 = C5 + 2 * 16 * 4;
        tr_kind(a.ffn_w_in, (bf16_t*)(a.ws + WS_WFI), 8, DM, FF2, FF2, 1, C0, tile, tid);
        tr_kind(a.ffn_w_out, (bf16_t*)(a.ws + WS_WFO), 8, FF, DM, DM, 0, C1, tile, tid);
        tr_kind(a.conv_w_in, (bf16_t*)(a.ws + WS_WCI), 2, DM, 3072, 3072, 2, C2, tile, tid);
        tr_kind(a.conv_w_out, (bf16_t*)(a.ws + WS_WCO), 2, DM, DM, DM, 0, C3, tile, tid);
        tr_kind(a.nsa_w_in, (bf16_t*)(a.ws + WS_WNI), 2, DM, NSA_IN, NSA_P, 0, C4, tile, tid);
        tr_kind(a.nsa_w_out, (bf16_t*)(a.ws + WS_WNO), 2, DM, DM, DM, 0, C5, tile, tid);
        tr_kind(a.cmp_w1, (bf16_t*)(a.ws + WS_WC1), 4, 2048, 256, 256, 3, C6, tile, tid);
    }
}

DI void phase_norm(const float* x, const float* g, const float* modL  , int sub, bf16_t* H, int wid, int lane) {
    const int gw = blockIdx.x * 8 + wid, NGW = gridDim.x * 8;
    for (int row = gw; row < TOK; row += NGW) {
        const int b = row >> 13;
        const float* sh = modL + b * 9216 + (sub * 3 + 0) * 1024; const float* sc = sh + 1024;
        const f32x4* xr = (const f32x4*)(x + (size_t)row * DM) + lane;
        f32x4 v[4]; float s = 0.f;
#pragma unroll
        for (int j = 0; j < 4; ++j) { v[j] = xr[64 * j]; s += (v[j].x * v[j].x + v[j].y * v[j].y) + (v[j].z * v[j].z + v[j].w * v[j].w); }
        const float rstd = rsqrtf(wave_sum(s, lane) * (1.f / DM) + RMS_EPS);
        u32x2* o8 = (u32x2*)(H + (size_t)row * DM) + lane;
#pragma unroll
        for (int j = 0; j < 4; ++j) {
            const f32x4 gg = ((const f32x4*)g)[lane + 64 * j], ss = ((const f32x4*)sc)[lane + 64 * j], hh = ((const f32x4*)sh)[lane + 64 * j];
            const f32x4 y = v[j] * rstd * gg * (ss + 1.0f) + hh;
            u32x2 w; w.x = pk2(y.x, y.y); w.y = pk2(y.z, y.w); o8[64 * j] = w;
        }
    }
}

DI void phase_conv_ew(const bf16_t* U, const bf16_t* Bg, const float* cw  , bf16_t* Wb, int tid) {
    const int gt = blockIdx.x * 512 + tid, NT = gridDim.x * 512;
    for (int idx = gt; idx < TOK * 128; idx += NT) {
        const int row = idx >> 7, c8 = (idx & 127) * 8, t = row & (SEQ - 1);
        const u32x4 u0 = *(const u32x4*)(U + (size_t)row * DM + c8);
        u32x4 u1 = {0u, 0u, 0u, 0u}, u2 = {0u, 0u, 0u, 0u};
        if (t >= 1) u1 = *(const u32x4*)(U + (size_t)(row - 1) * DM + c8);
        if (t >= 2) u2 = *(const u32x4*)(U + (size_t)(row - 2) * DM + c8);
        const u32x4 bg = *(const u32x4*)(Bg + (size_t)row * DM + c8);
        float k0[8], k1[8], k2[8];
        { const f32x4 a0 = *(const f32x4*)(cw + c8), a1 = *(const f32x4*)(cw + c8 + 4), b0 = *(const f32x4*)(cw + 1024 + c8), b1 = *(const f32x4*)(cw + 1024 + c8 + 4),
                      c0 = *(const f32x4*)(cw + 2048 + c8), c1 = *(const f32x4*)(cw + 2048 + c8 + 4);
#pragma unroll
          for (int j = 0; j < 4; ++j) { k0[j] = a0[j]; k0[4 + j] = a1[j]; k1[j] = b0[j]; k1[4 + j] = b1[j]; k2[j] = c0[j]; k2[4 + j] = c1[j]; } }
        u32x4 o;
#pragma unroll
        for (int e = 0; e < 4; ++e) {
            const float ylo = k0[2 * e] * lo_f(u2[e]) + k1[2 * e] * lo_f(u1[e]) + k2[2 * e] * lo_f(u0[e]);
            const float yhi = k0[2 * e + 1] * hi_f(u2[e]) + k1[2 * e + 1] * hi_f(u1[e]) + k2[2 * e + 1] * hi_f(u0[e]);
            o[e] = pk2(lo_f(bg[e]) * ylo, hi_f(bg[e]) * yhi);
        }
        *(u32x4*)(Wb + (size_t)row * DM + c8) = o;
    }
}

DI void norm64_store(const bf16_t* src, const float* gain, float mul, bf16_t* dst) {
    u32x4 v[8]; float ss = 0.f;
#pragma unroll
    for (int i = 0; i < 8; ++i) { v[i] = ((const u32x4*)src)[i];
#pragma unroll
        for (int e = 0; e < 4; ++e) { const float a = lo_f(v[i][e]), b = hi_f(v[i][e]); ss += a * a + b * b; } }
    const float r = rsqrtf(ss * (1.f / 64.f) + RMS_EPS) * mul;
#pragma unroll
    for (int i = 0; i < 8; ++i) { u32x4 o;
#pragma unroll
        for (int e = 0; e < 4; ++e) o[e] = pk2(lo_f(v[i][e]) * r * gain[i * 8 + 2 * e], hi_f(v[i][e]) * r * gain[i * 8 + 2 * e + 1]);
        ((u32x4*)dst)[i] = o; }
}
DI void phase_nsa_prep(const Args& a, int lj, LAS unsigned char* lds, int tid) {
    const int lane = tid & 63;
    const bf16_t* P = (const bf16_t*)(a.ws + WS_HID);
    bf16_t* Qn = (bf16_t*)(a.ws + WS_QN); bf16_t* KcT = (bf16_t*)(a.ws + WS_KCT); bf16_t* Ksel = (bf16_t*)(a.ws + WS_KSEL); bf16_t* Kwin = (bf16_t*)(a.ws + WS_KWIN);
    bf16_t* VselT = (bf16_t*)(a.ws + WS_VSELT); bf16_t* VwinT = (bf16_t*)(a.ws + WS_VWINT); float* Gates = (float*)(a.ws + WS_GATES);
    const float* qg = a.q_gain + lj * 64; const float* kg = a.k_gain + lj * 192;
    LAS bf16_t* tl = (LAS bf16_t*)lds;
    for (int u = blockIdx.x; u < TOK / 64; u += gridDim.x) {
        const int rowbase = u * 64, b = rowbase >> 13, tb = rowbase & (SEQ - 1);
#pragma unroll 4
        for (int it = 0; it < 16; ++it) {
            const int item = tid + it * 512, ch = item & 7, head = (item >> 3) & 15, tok = item >> 7;
            const u32x4 v = *(const u32x4*)(P + (size_t)(rowbase + tok) * NSA_P + head * 64 + ch * 8);
            float ss = 0.f;
#pragma unroll
            for (int e = 0; e < 4; ++e) { const float x0 = lo_f(v[e]), x1 = hi_f(v[e]); ss += x0 * x0 + x1 * x1; }
            ss += shx(ss, 1, lane); ss += shx(ss, 2, lane); ss += shx(ss, 4, lane);
            const float r = rsqrtf(ss * (1.f / 64.f) + RMS_EPS) * (0.125f * 1.4426950408889634f);
            u32x4 o;
#pragma unroll
            for (int e = 0; e < 4; ++e) o[e] = pk2(lo_f(v[e]) * r * qg[ch * 8 + 2 * e], hi_f(v[e]) * r * qg[ch * 8 + 2 * e + 1]);
            *(u32x4*)(Qn + (size_t)(rowbase + tok) * DM + head * 64 + ch * 8) = o;
        }
#pragma unroll 4
        for (int it = 0; it < 8; ++it) {
            const int item = tid + it * 512, ch = item & 7, g = (item >> 3) & 3, kind = (item >> 5) & 1, tok = item >> 6;
            const u32x4 v = *(const u32x4*)(P + (size_t)(rowbase + tok) * NSA_P + (kind ? 2048 : 1536) + g * 64 + ch * 8);
            float ss = 0.f;
#pragma unroll
            for (int e = 0; e < 4; ++e) { const float x0 = lo_f(v[e]), x1 = hi_f(v[e]); ss += x0 * x0 + x1 * x1; }
            ss += shx(ss, 1, lane); ss += shx(ss, 2, lane); ss += shx(ss, 4, lane);
            const float r = rsqrtf(ss * (1.f / 64.f) + RMS_EPS);
            const float* gn = kg + (1 + kind) * 64 + ch * 8;
            u32x4 o;
#pragma unroll
            for (int e = 0; e < 4; ++e) o[e] = pk2(lo_f(v[e]) * r * gn[2 * e], hi_f(v[e]) * r * gn[2 * e + 1]);
            *(u32x4*)((kind ? Kwin : Ksel) + ((size_t)(b * 4 + g) * SEQ + tb + tok) * 64 + ch * 8) = o;
            const u32x4 w = *(const u32x4*)(P + (size_t)(rowbase + tok) * NSA_P + 1024 + kind * 256 + g * 64 + ch * 8);
            *(u32x4*)(KcT + ((size_t)(kind * 8 + b * 4 + g) * SEQ + tb + tok) * 64 + ch * 8) = w;
        }
        for (int kind = 0; kind < 2; ++kind) {
            const int cbase = kind ? 2304 : 1792; bf16_t* VT = kind ? VwinT : VselT;
#pragma unroll
            for (int k = 0; k < 4; ++k) { const int idx = tid + k * 512, tok = idx >> 5, c16 = idx & 31;
                *(LAS u32x4*)(tl + tok * 264 + c16 * 8) = *(const u32x4*)(P + (size_t)(rowbase + tok) * NSA_P + cbase + c16 * 8); }
            __syncthreads();
#pragma unroll
            for (int k = 0; k < 4; ++k) { const int idx = tid + k * 512, col = idx >> 3, ch = idx & 7;
                unsigned short e[8];
#pragma unroll
                for (int j = 0; j < 8; ++j) e[j] = tl[(ch * 8 + j) * 264 + col];
                u32x4 o; o.x = e[0] | ((unsigned)e[1] << 16); o.y = e[2] | ((unsigned)e[3] << 16); o.z = e[4] | ((unsigned)e[5] << 16); o.w = e[6] | ((unsigned)e[7] << 16);
                *(u32x4*)(VT + ((size_t)(b * 4 + (col >> 6)) * 64 + (col & 63)) * SEQ + tb + ch * 8) = o; }
            __syncthreads();
        }
        for (int idx = tid; idx < 64 * 48; idx += 512) { const int tok = idx / 48, c = idx % 48;
            Gates[(size_t)(rowbase + tok) * 48 + c] = sigmoidf_(bf2f(P[(size_t)(rowbase + tok) * NSA_P + 2560 + c])); }
    }
}

DI void phase_cmp2(const Args& a, int lj, LAS unsigned char* lds, int tid, int wid, int lane) {
    const float* H1 = (const float*)(a.ws + WS_Y1); const float* bias1 = (const float*)(a.ws + WS_BIAS1) + lj * 512; bf16_t* Kcmp = (bf16_t*)(a.ws + WS_KCMP); bf16_t* VcmpT = (bf16_t*)(a.ws + WS_VCMPT);
    LAS float* w2s = (LAS float*)lds;
    { const f32x4* src = (const f32x4*)(a.cmp_w2 + (size_t)lj * 2 * 256 * 64);
#pragma unroll 4
      for (int i = tid; i < 8192; i += 512) { const f32x4 v = src[i]; LAS float* d = w2s + i * 4; d[0] = v.x; d[1] = v.y; d[2] = v.z; d[3] = v.w; } }
    __syncthreads();
    const int gw = blockIdx.x * 8 + wid, NGW = gridDim.x * 8;
    for (int r = gw; r < 8192; r += NGW) {
        const int z = r >> 9, n = r & 511, kind = z >> 3, bg = z & 7;
        float acc = 0.f;
        if (n < 511) {
            f32x4 hv = *((const f32x4*)(H1 + (size_t)r * 512) + lane) + *((const f32x4*)(H1 + (size_t)(r + 1) * 512 + 256) + lane) + *((const f32x4*)(bias1 + kind * 256) + lane);
#pragma unroll
            for (int e = 0; e < 4; ++e) { const float t = hv[e], uu = 0.7978845608f * (t + 0.044715f * t * t * t); hv[e] = t * __builtin_amdgcn_rcpf(1.0f + __expf(-2.0f * uu)); }
            const LAS float* w = w2s + kind * 16384 + lane;
#pragma unroll 4
            for (int l = 0; l < 64; ++l) {
                const float h0 = __int_as_float(__builtin_amdgcn_readlane(__float_as_int(hv.x), l)), h1 = __int_as_float(__builtin_amdgcn_readlane(__float_as_int(hv.y), l)), h2 = __int_as_float(__builtin_amdgcn_readlane(__float_as_int(hv.z), l)), h3 = __int_as_float(__builtin_amdgcn_readlane(__float_as_int(hv.w), l));
                acc += h0 * w[(4 * l) * 64]; acc += h1 * w[(4 * l + 1) * 64]; acc += h2 * w[(4 * l + 2) * 64]; acc += h3 * w[(4 * l + 3) * 64];
            }
        }
        if (kind == 0) {
            const float ss = wave_sum(acc * acc, lane);
            const float y = acc * rsqrtf(ss * (1.f / 64.f) + RMS_EPS) * a.k_gain[lj * 192 + lane];
            Kcmp[((size_t)bg * 512 + n) * 64 + lane] = (bf16_t)(pk2(y, 0.f) & 0xffffu);
        } else {
            VcmpT[((size_t)bg * 64 + lane) * 512 + n] = (bf16_t)(pk2(acc, 0.f) & 0xffffu);
        }
    }
}

DI int t5_bucket(int n) {
    if (n < 16) return n;
    int b = 16;
    b += (n >= 19) + (n >= 21) + (n >= 24) + (n >= 27) + (n >= 31) + (n >= 35) + (n >= 40) + (n >= 46) + (n >= 52) + (n >= 59) + (n >= 67) + (n >= 77) + (n >= 87) + (n >= 99) + (n >= 113);
    return b;
}
#define MFMA16(a, b, c) __builtin_amdgcn_mfma_f32_16x16x32_bf16((a), (b), (c), 0, 0, 0)

constexpr int AT_LUT = 0, AT_UM = 8256, AT_IMP = 8448, AT_Q = 74752, AT_STG = 140288, AT_STGV = AT_STG + 9216, AT_END = AT_STGV + 9216;
static_assert(AT_END <= LDS_BYTES, "attention LDS map");
constexpr int SROW = 144;

template <int KIND, bool DO_L, bool DO_IMP, bool DO_PV>
DI void attn_step(const LAS unsigned char* kst, const LAS unsigned char* vst, int key0, int token, int t0, bool selbit,
                  const bf16x8 (&Qf)[4][2], f32x4 (&acc)[4][4], float (&l)[4], const float (&pn)[4],
                  const LAS float* lut, const f32x4 b31, LAS float* impw, int c, int q) {
    bf16x8 Pf[4]; unsigned plo[4][2];
    const int maxkey = key0 + 31;
    bool far = (KIND == 0) ? (t0 - (16 * maxkey + 31) >= 128) : (t0 - maxkey >= 128);
    if (KIND == 3) far = far && (t0 + 15 - key0 < 512);
    const float mv = (KIND == 2 && far && !selbit) ? -1e30f : 0.f;
    const f32x4 cm = {mv, mv, mv, mv};
    bf16x8 kf[2][2];
#pragma unroll
    for (int sub = 0; sub < 2; ++sub) { const LAS unsigned char* kp = kst + (16 * sub + c) * SROW + q * 16; kf[sub][0] = *(const LAS bf16x8*)kp; kf[sub][1] = *(const LAS bf16x8*)(kp + 64); }
#pragma unroll
    for (int sub = 0; sub < 2; ++sub) {
        const int kbase = key0 + 16 * sub;
        const bf16x8 k0 = kf[sub][0], k1 = kf[sub][1];
        f32x4 S[4];
#pragma unroll
        for (int hg = 0; hg < 4; ++hg) { S[hg] = MFMA16(k0, Qf[hg][0], cm); S[hg] = MFMA16(k1, Qf[hg][1], S[hg]); }
        float pv[4][4]; float ia = 0.f, ib = 0.f;
        if (far) {
#pragma unroll
            for (int i = 0; i < 4; ++i)
#pragma unroll
                for (int hg = 0; hg < 4; ++hg) {
                    float p = __builtin_amdgcn_exp2f(S[hg][i]);
                    if (DO_L) l[hg] += p;
                    if (DO_IMP) p *= pn[hg];
                    if (DO_IMP) { ia += p; if (i == 3) ib += p; }
                    pv[hg][i] = p;
                }
        } else {
#pragma unroll
            for (int i = 0; i < 4; ++i) {
                const int kidx = kbase + 4 * q + i;
                int dist; bool valid;
                if (KIND == 0) { dist = token - (16 * kidx + 31); valid = dist >= 0; }
                else if (KIND == 2) { dist = token - kidx; valid = selbit && dist >= 0; }
                else { dist = token - kidx; valid = dist >= 0 && dist < 512; }
                const int di = dist < 0 ? 0 : (dist > 128 ? 128 : dist);
                const f32x4 b4 = *(const LAS f32x4*)(lut + di * 16);
#pragma unroll
                for (int hg = 0; hg < 4; ++hg) {
                    float p = valid ? __builtin_amdgcn_exp2f(S[hg][i] + b4[hg]) : 0.f;
                    if (DO_L) l[hg] += p;
                    if (DO_IMP) p *= pn[hg];
                    if (DO_IMP) { ia += p; if (i == 3) ib += p; }
                    pv[hg][i] = p;
                }
            }
        }
        if (DO_IMP) {
            const int s = (kbase >> 2) + q;
            impw[c * 129 + s] += ia;
            asm volatile("" ::: "memory");
            if (s + 1 < 128) impw[c * 129 + s + 1] += ib;
            asm volatile("" ::: "memory");
        }
        if (DO_PV) {
#pragma unroll
            for (int hg = 0; hg < 4; ++hg) {
                const unsigned w0 = pk2(pv[hg][0], pv[hg][1]), w1 = pk2(pv[hg][2], pv[hg][3]);
                if (sub == 0) { plo[hg][0] = w0; plo[hg][1] = w1; }
                else { u32x4 w = {plo[hg][0], plo[hg][1], w0, w1}; Pf[hg] = __builtin_bit_cast(bf16x8, w); }
            }
        }
    }
    if (DO_PV) {
        bf16x8 Vf[4];
#pragma unroll
        for (int dt = 0; dt < 4; ++dt) { const LAS unsigned char* vp = vst + (16 * dt + c) * SROW + q * 8;
            const u32x2 lo = *(const LAS u32x2*)vp, hi = *(const LAS u32x2*)(vp + 32); const u32x4 vv = {lo.x, lo.y, hi.x, hi.y}; Vf[dt] = __builtin_bit_cast(bf16x8, vv); }
        __builtin_amdgcn_sched_barrier(0);
#pragma unroll
        for (int dt = 0; dt < 4; ++dt)
#pragma unroll
            for (int hg = 0; hg < 4; ++hg) acc[hg][dt] = MFMA16(Vf[dt], Pf[hg], acc[hg][dt]);
    }
}

typedef unsigned long long u64;
DI bool um_bit(u64 lo, u64 hi, int s) { const u64 w = (s < 64) ? lo : hi; return ((w >> (s & 63)) & 1ull) != 0ull; }

template <int KIND, bool DO_L, bool DO_IMP, bool DO_PV>
DI void attn_stream(const bf16_t* __restrict__ Kg, const bf16_t* __restrict__ Vtg, int vstride, int blk_lo, int blk_hi, u64 uml, u64 umh, const LAS unsigned* selw,
                    int ti, int token, int t0, LAS unsigned char* lds, const bf16x8 (&Qf)[4][2], f32x4 (&acc)[4][4], float (&l)[4], const float (&pn)[4],
                    const LAS float* lut, const f32x4 b31, LAS float* impw, int c, int q, int tid) {
    const int srow = tid >> 3, sch = tid & 7;
    const int soff = srow * SROW + sch * 16;
    constexpr bool DB = !DO_IMP;
    constexpr int ALT = AT_IMP - AT_STG;
    int blk = blk_lo;
    if (KIND == 2) while (blk <= blk_hi && !um_bit(uml, umh, blk)) ++blk;
    u32x4 rk = {0u, 0u, 0u, 0u}, rv = {0u, 0u, 0u, 0u};
    if (blk <= blk_hi) { rk = *(const u32x4*)(Kg + (size_t)(64 * blk + srow) * 64 + sch * 8); if (DO_PV) rv = *(const u32x4*)(Vtg + (size_t)srow * vstride + 64 * blk + sch * 8); }
    int boff = 0;
    if (DB) { *(LAS u32x4*)(lds + AT_STG + soff) = rk; if (DO_PV) *(LAS u32x4*)(lds + AT_STGV + soff) = rv; __syncthreads(); }
#pragma unroll 1
    while (blk <= blk_hi) {
        if (!DB) { *(LAS u32x4*)(lds + AT_STG + soff) = rk; if (DO_PV) *(LAS u32x4*)(lds + AT_STGV + soff) = rv; __syncthreads(); }
        int nb = blk + 1;
        if (KIND == 2) while (nb <= blk_hi && !um_bit(uml, umh, nb)) ++nb;
        if (nb <= blk_hi) { rk = *(const u32x4*)(Kg + (size_t)(64 * nb + srow) * 64 + sch * 8); if (DO_PV) rv = *(const u32x4*)(Vtg + (size_t)srow * vstride + 64 * nb + sch * 8); }
        bool sb = true;
        if (KIND == 2) sb = ((selw[c * 4 + (blk >> 5)] >> (blk & 31)) & 1u) != 0u && (64 * blk <= token);
#pragma unroll 1
        for (int hh = 0; hh < 2; ++hh) {
            const int key0 = 64 * blk + 32 * hh;
            bool need;
            if (KIND == 0) need = key0 <= ti - 1;
            else if (KIND == 2) need = __ballot(sb) != 0ull;
            else need = (key0 <= t0 + 15) && (key0 + 31 >= t0 - 511);
            if (need) attn_step<KIND, DO_L, DO_IMP, DO_PV>(lds + AT_STG + boff + hh * 32 * SROW, lds + AT_STGV + boff + hh * 64, key0, token, t0, sb, Qf, acc, l, pn, lut, b31, impw, c, q);
        }
        if (DB) { boff ^= ALT; if (nb <= blk_hi) { *(LAS u32x4*)(lds + AT_STG + boff + soff) = rk; if (DO_PV) *(LAS u32x4*)(lds + AT_STGV + boff + soff) = rv; } }
        __syncthreads();
        blk = nb;
    }
}

DI void phase_attn(const Args& a, LAS unsigned char* lds, int tid, int wid, int lane) {
    LAS float* lutall = (LAS float*)(lds + AT_LUT);
    LAS unsigned* umw = (LAS unsigned*)(lds + AT_UM);
    LAS float* impw = (LAS float*)(lds + AT_IMP) + wid * (16 * 129);
    LAS unsigned char* qs = lds + AT_Q + wid * 8192 + lane * 16;
    for (int i = tid; i < 129 * 16; i += 512) { const int d = i >> 4, h = i & 15; lutall[i] = (a.rel_bias[t5_bucket(d) * 16 + h] - a.rel_bias[31 * 16 + h]) * 1.4426950408889634f; }
    __syncthreads();
    const int c = lane & 15, q = lane >> 4;
    if (wid >= 4) __builtin_amdgcn_s_setprio(1);
#pragma unroll 1
    for (int pidx = blockIdx.x; pidx < 256; pidx += gridDim.x) {
        const int bg = pidx >> 5, jj = pidx & 31, b = bg >> 2, g = bg & 3;
        size_t zoff = 0; asm volatile("" : "+s"(zoff)); unsigned char* wsl = a.ws + zoff;
        const bf16_t* Qn = (const bf16_t*)(wsl + WS_QN); const bf16_t* Ksel = (const bf16_t*)(wsl + WS_KSEL) + (size_t)bg * SEQ * 64; const bf16_t* Kwin = (const bf16_t*)(wsl + WS_KWIN) + (size_t)bg * SEQ * 64;
        const bf16_t* VselT = (const bf16_t*)(wsl + WS_VSELT) + (size_t)bg * 64 * SEQ; const bf16_t* VwinT = (const bf16_t*)(wsl + WS_VWINT) + (size_t)bg * 64 * SEQ;
        const bf16_t* Kc = (const bf16_t*)(wsl + WS_KCMP) + (size_t)bg * 512 * 64; const bf16_t* Vc = (const bf16_t*)(wsl + WS_VCMPT) + (size_t)bg * 64 * 512;
        const float* Gates = (const float*)(wsl + WS_GATES); bf16_t* O = (bf16_t*)(wsl + WS_HB);
        const LAS float* lut = lutall + g * 4;
        f32x4 b31;
#pragma unroll
        for (int hg = 0; hg < 4; ++hg) b31[hg] = a.rel_bias[31 * 16 + g * 4 + hg] * 1.4426950408889634f;
#pragma unroll 1
        for (int which = 0; which < 2; ++which) {
            const int tb = which ? 63 - jj : jj, ti = tb * 8 + wid, t0 = ti * 16, token = t0 + c;
            const size_t row = (size_t)b * SEQ + token;
            const float* grow = Gates + row * 48 + g * 12;
            bf16x8 Qf[4][2];
#pragma unroll
            for (int k = 0; k < 8; ++k) Qf[k >> 1][k & 1] = *(const bf16x8*)(Qn + row * DM + (g * 4 + (k >> 1)) * 64 + (k & 1) * 32 + 8 * q);
            if (tid < 4) umw[tid] = 0u;
            f32x4 acc[4][4];
            float l[4] = {0.f, 0.f, 0.f, 0.f}, pn[4] = {1.f, 1.f, 1.f, 1.f}, pnc[4];
            u64 uml = 0ull, umh = 0ull;
            LAS unsigned* selw = (LAS unsigned*)(lds + AT_Q) + wid * 64;
            const int cblk_hi = (tb * 8 + 7 - 1) >> 6;
            float* park = (float*)(wsl + WS_DUMMY) + row * DM + (size_t)g * 256 + 4 * q;
#pragma unroll
            for (int hg = 0; hg < 4; ++hg)
#pragma unroll
                for (int dt = 0; dt < 4; ++dt) acc[hg][dt] = (f32x4){0.f, 0.f, 0.f, 0.f};
            attn_stream<0, true, false, true>(Kc, Vc, 512, 0, cblk_hi, uml, umh, selw, ti, token, t0, lds, Qf, acc, l, pn, lut, b31, impw, c, q, tid);
#pragma unroll
            for (int hg = 0; hg < 4; ++hg) { float s = l[hg]; s += shx(s, 16, lane); s += shx(s, 32, lane); pnc[hg] = s > 0.f ? 1.0f / s : 0.f; l[hg] = 0.f;
                const float f = pnc[hg] * grow[hg * 3 + 0];
#pragma unroll
                for (int dt = 0; dt < 4; ++dt) *(f32x4*)(park + hg * 64 + dt * 16) = acc[hg][dt] * f; }
            for (int i = lane; i < 16 * 129; i += 64) impw[i] = 0.f;
            attn_stream<0, false, true, false>(Kc, Vc, 512, 0, cblk_hi, uml, umh, selw, ti, token, t0, lds, Qf, acc, l, pnc, lut, b31, impw, c, q, tid);
            unsigned selm = 0u;
            {
                const int cur = token >> 6;
                float NEGI = -1e30f, FORCE = 1e9f, GONE = -3e38f; asm volatile("" : "+v"(NEGI), "+v"(FORCE), "+v"(GONE));
                float v[32];
                const int cr = cur - 32 * q; const bool q0 = (q == 0); const LAS float* ip = impw + c * 129 + 32 * q;
#pragma unroll
                for (int k = 0; k < 32; ++k) { float x = ip[k];
                    if (k > cr) x = NEGI;
                    if ((k == 0 && q0) || k == cr || k == cr - 1) x = FORCE;
                    v[k] = x; }
#pragma unroll 1
                for (int r = 0; r < 16; ++r) {
                    float best = v[0]; int bi = 0;
#pragma unroll
                    for (int k = 1; k < 32; ++k) { if (v[k] > best) { best = v[k]; bi = k; } }
                    int gi = 32 * q + bi;
#pragma unroll
                    for (int off = 16; off <= 32; off <<= 1) { const float ob = shx(best, off, lane); const int oi = shxi(gi, off, lane); if (ob > best || (ob == best && oi < gi)) { best = ob; gi = oi; } }
                    const bool mine = (gi >> 5) == q; const int kk = gi & 31;
#pragma unroll
                    for (int k = 0; k < 32; ++k) if (mine && k == kk) v[k] = GONE;
                    if (mine) selm |= 1u << kk;
                }
            }
            selw[c * 4 + q] = selm;
            atomicOr((unsigned*)(umw + q), selm);
            __syncthreads();
            { const unsigned u0 = __builtin_amdgcn_readfirstlane(umw[0]), u1 = __builtin_amdgcn_readfirstlane(umw[1]), u2 = __builtin_amdgcn_readfirstlane(umw[2]), u3 = __builtin_amdgcn_readfirstlane(umw[3]);
              uml = (u64)u0 | ((u64)u1 << 32); umh = (u64)u2 | ((u64)u3 << 32); }
            {
                int wlo = tb * 128 - 511; if (wlo < 0) wlo = 0; wlo >>= 6;
#pragma unroll
                for (int hg = 0; hg < 4; ++hg)
#pragma unroll
                    for (int dt = 0; dt < 4; ++dt) acc[hg][dt] = (f32x4){0.f, 0.f, 0.f, 0.f};
                attn_stream<3, true, false, true>(Kwin, VwinT, SEQ, wlo, 2 * tb + 1, uml, umh, selw, ti, token, t0, lds, Qf, acc, l, pn, lut, b31, impw, c, q, tid);
#pragma unroll
                for (int hg = 0; hg < 4; ++hg) { float s = l[hg]; s += shx(s, 16, lane); s += shx(s, 32, lane); const float f = s > 0.f ? grow[hg * 3 + 2] / s : 0.f; l[hg] = 0.f;
#pragma unroll
                    for (int dt = 0; dt < 4; ++dt) { f32x4* pp = (f32x4*)(park + hg * 64 + dt * 16); *pp = *pp + acc[hg][dt] * f; } }
            }
#pragma unroll
            for (int hg = 0; hg < 4; ++hg)
#pragma unroll
                for (int dt = 0; dt < 4; ++dt) acc[hg][dt] = (f32x4){0.f, 0.f, 0.f, 0.f};
            attn_stream<2, true, false, true>(Ksel, VselT, SEQ, 0, 2 * tb + 1, uml, umh, selw, ti, token, t0, lds, Qf, acc, l, pn, lut, b31, impw, c, q, tid);
#pragma unroll
            for (int hg = 0; hg < 4; ++hg) { float s = l[hg]; s += shx(s, 16, lane); s += shx(s, 32, lane); const float f = s > 0.f ? grow[hg * 3 + 1] / s : 0.f; l[hg] = 0.f;
#pragma unroll
                for (int dt = 0; dt < 4; ++dt) acc[hg][dt] = acc[hg][dt] * f + *(const f32x4*)(park + hg * 64 + dt * 16); }
#pragma unroll
            for (int hg = 0; hg < 4; ++hg)
#pragma unroll
                for (int dt = 0; dt < 4; ++dt) { u32x2 w; w.x = pk2(acc[hg][dt][0], acc[hg][dt][1]); w.y = pk2(acc[hg][dt][2], acc[hg][dt][3]);
                    *(u32x2*)(O + row * DM + (g * 4 + hg) * 64 + 16 * dt + 4 * q) = w; }
        }
    }
    __builtin_amdgcn_s_setprio(0);
}


#ifdef SELFTEST
constexpr size_t WS_FLAG = 900 * 1024;
DI void phase_selftest(const Args& a, LAS unsigned char* lds, int wid, int lane) {
    const bf16_t* Qn = (const bf16_t*)(a.ws + WS_QN); const float* Gates = (const float*)(a.ws + WS_GATES); const bf16_t* O = (const bf16_t*)(a.ws + WS_HB);
    LAS float* W = (LAS float*)(lds + wid * 16384);
    LAS float* qv = W; LAS float* pc = W + 64; LAS float* imp = W + 576; LAS float* ps = W + 704; LAS float* pw = W + 1728; LAS float* outv = W + 2240; LAS int* sels = (LAS int*)(W + 2496);
    const float L2E = 1.4426950408889634f;
    const int gw = blockIdx.x * 8 + wid, NGW = gridDim.x * 8;
    for (int task = gw; task < 8 * 144; task += NGW) {
        const int bg = task / 144, k = task % 144, b = bg >> 2, g = bg & 3;
        int t;
        if (k < 128) t = k * 64 + (k * 37) % 64;
        else { const int ed[16] = {0, 1, 15, 30, 31, 32, 47, 63, 64, 65, 511, 512, 513, 4095, 4096, 8191}; t = ed[k - 128]; }
        const size_t row = (size_t)b * SEQ + t;
        const bf16_t* Kc = (const bf16_t*)(a.ws + WS_KCMP) + (size_t)bg * 512 * 64; const bf16_t* Vc = (const bf16_t*)(a.ws + WS_VCMPT) + (size_t)bg * 64 * 512;
        const bf16_t* Ks = (const bf16_t*)(a.ws + WS_KSEL) + (size_t)bg * SEQ * 64; const bf16_t* Vs = (const bf16_t*)(a.ws + WS_VSELT) + (size_t)bg * 64 * SEQ;
        const bf16_t* Kw = (const bf16_t*)(a.ws + WS_KWIN) + (size_t)bg * SEQ * 64; const bf16_t* Vw = (const bf16_t*)(a.ws + WS_VWINT) + (size_t)bg * 64 * SEQ;
        for (int i = lane; i < 128; i += 64) imp[i] = 0.f;
        for (int i = lane; i < 256; i += 64) outv[i] = 0.f;
        const int ncv = (t >= 31) ? (t - 31) / 16 + 1 : 0;
        for (int hg = 0; hg < 4; ++hg) {
            const int h = g * 4 + hg;
            qv[lane] = bf2f(Qn[row * DM + h * 64 + lane]);
            float lsum = 0.f;
            for (int n = lane; n < 512; n += 64) {
                float p = 0.f;
                if (n < ncv) { float sdot = 0.f; for (int d = 0; d < 64; ++d) sdot += qv[d] * bf2f(Kc[n * 64 + d]);
                    const int dist = t - (16 * n + 31); p = exp2f(sdot + a.rel_bias[t5_bucket(dist) * 16 + h] * L2E); }
                pc[n] = p; lsum += p;
            }
            lsum = wave_sum(lsum, lane);
            const float inv = lsum > 0.f ? 1.f / lsum : 0.f;
            for (int n = lane; n < 512; n += 64) pc[n] *= inv;
            for (int s2 = lane; s2 < 128; s2 += 64) { float acc = 0.f; for (int n = 4 * s2 - 1; n <= 4 * s2 + 3; ++n) if (n >= 0 && n < 511) acc += pc[n]; imp[s2] += acc; }
            { float o = 0.f; for (int n = 0; n < ncv; ++n) o += pc[n] * bf2f(Vc[lane * 512 + n]); outv[hg * 64 + lane] += Gates[row * 48 + h * 3 + 0] * o; }
        }
        const int cur = t >> 6;
        float v0, v1;
        { int s0 = lane, s1 = lane + 64; v0 = imp[s0]; v1 = imp[s1];
          if (s0 > cur) v0 = -1e30f; if (s1 > cur) v1 = -1e30f;
          if (s0 == 0 || s0 == cur || s0 == cur - 1) v0 = 1e9f; if (s1 == cur || s1 == cur - 1) v1 = 1e9f; }
        for (int r = 0; r < 16; ++r) {
            float best = v0; int bi = lane; if (v1 > best) { best = v1; bi = lane + 64; }
            for (int off = 1; off < 64; off <<= 1) { const float ob = shx(best, off, lane); const int oi = shxi(bi, off, lane); if (ob > best || (ob == best && oi < bi)) { best = ob; bi = oi; } }
            if (bi == lane) v0 = -3e38f; if (bi == lane + 64) v1 = -3e38f;
            if (lane == 0) sels[r] = bi;
        }
        for (int hg = 0; hg < 4; ++hg) {
            const int h = g * 4 + hg;
            qv[lane] = bf2f(Qn[row * DM + h * 64 + lane]);
            float lsum = 0.f;
            for (int r = 0; r < 16; ++r) {
                const int sb = sels[r], pos = sb * 64 + lane; float p = 0.f;
                if (pos <= t) { float sdot = 0.f; for (int d = 0; d < 64; ++d) sdot += qv[d] * bf2f(Ks[(size_t)pos * 64 + d]); p = exp2f(sdot + a.rel_bias[t5_bucket(t - pos) * 16 + h] * L2E); }
                ps[r * 64 + lane] = p; lsum += p;
            }
            lsum = wave_sum(lsum, lane);
            { float o = 0.f; for (int r = 0; r < 16; ++r) { const int sb = sels[r]; if (sb * 64 > t) continue; for (int kk = 0; kk < 64; ++kk) o += ps[r * 64 + kk] * bf2f(Vs[(size_t)lane * SEQ + sb * 64 + kk]); }
              outv[hg * 64 + lane] += (lsum > 0.f ? Gates[row * 48 + h * 3 + 1] / lsum : 0.f) * o; }
            lsum = 0.f;
            for (int j = lane; j < 512; j += 64) { const int pos = t - j; float p = 0.f;
                if (pos >= 0) { float sdot = 0.f; for (int d = 0; d < 64; ++d) sdot += qv[d] * bf2f(Kw[(size_t)pos * 64 + d]); p = exp2f(sdot + a.rel_bias[t5_bucket(j) * 16 + h] * L2E); }
                pw[j] = p; lsum += p; }
            lsum = wave_sum(lsum, lane);
            { float o = 0.f; for (int j = 0; j < 512; ++j) { const int pos = t - j; if (pos < 0) break; o += pw[j] * bf2f(Vw[(size_t)lane * SEQ + pos]); }
              outv[hg * 64 + lane] += (lsum > 0.f ? Gates[row * 48 + h * 3 + 2] / lsum : 0.f) * o; }
        }
        float mx = 0.f, md = 0.f;
        for (int i = lane; i < 256; i += 64) { const float r0 = outv[i], o0 = bf2f(O[row * DM + g * 256 + i]); mx = fmaxf(mx, fabsf(r0)); md = fmaxf(md, fabsf(r0 - o0)); }
        for (int off = 1; off < 64; off <<= 1) { mx = fmaxf(mx, shx(mx, off, lane)); md = fmaxf(md, shx(md, off, lane)); }
        if (lane == 0) { unsigned* fl = (unsigned*)(a.ws + WS_FLAG); if (!(md <= 0.03f * mx + 1e-4f)) atomicAdd(fl, 1u); atomicAdd(fl + 1, 1u); }
    }
}
#endif

constexpr size_t WS_BAR = 800 * 1024;
constexpr int LDS_BARST = 159744;
#define XB_TMO      128
#define XB_XCNT(j)  (256  + 64 * (j))
#define XB_XSUB(j)  (1280 + 64 * (j))
#define XB_XGEN(j)  (2304 + 64 * (j))
#define XB_TOP      3328
#define XB_TOPGEN   3392
#define XCD_BAR_WORDS 3456
#define XB_SPIN_CAP (1u << 22)
DI unsigned xb_ld(unsigned* p)              { return __hip_atomic_load(p, __ATOMIC_RELAXED, __HIP_MEMORY_SCOPE_AGENT); }
DI unsigned xb_add(unsigned* p, unsigned v) { return __hip_atomic_fetch_add(p, v, __ATOMIC_RELAXED, __HIP_MEMORY_SCOPE_AGENT); }
DI unsigned xb_xcc_id() { return (unsigned)__builtin_amdgcn_s_getreg((3 << 11) | 20) & 0xFu; }
#define XB_SPIN(cond, bar) do { unsigned _sp = 0; while (cond) { __builtin_amdgcn_s_sleep(1); \
    if ((++_sp & 255u) == 0u) { if (xb_ld(&(bar)[XB_TMO])) break; if (_sp > XB_SPIN_CAP) { atomicAdd(&(bar)[XB_TMO], 1u); break; } } } } while (0)
struct XcdBarrier { unsigned* bar; unsigned x; volatile LAS unsigned* st; };
DI XcdBarrier xcd_barrier_post(unsigned* bar, volatile LAS unsigned* st) {
    XcdBarrier b; b.bar = bar; b.x = xb_xcc_id(); b.st = st;
    if (threadIdx.x == 0) (void)xb_add(&bar[XB_XCNT(b.x)], 1u);
    return b;
}
DI void xcd_barrier_complete(unsigned* bar, unsigned x, unsigned& nloc, unsigned& nx) {
    const unsigned G = gridDim.x * gridDim.y * gridDim.z;
    unsigned sum, cnt, mine, sp = 0u;
    for (;;) {
        sum = 0u; cnt = 0u; mine = 0u;
#pragma unroll
        for (unsigned j = 0; j < 16; ++j) { const unsigned c = xb_ld(&bar[XB_XCNT(j)]); sum += c; cnt += (c > 0u) ? 1u : 0u; mine = (j == x) ? c : mine; }
        if (sum == G) break;
        __builtin_amdgcn_s_sleep(1);
        if ((++sp & 255u) == 0u) { if (xb_ld(&bar[XB_TMO])) break; if (sp > XB_SPIN_CAP) { atomicAdd(&bar[XB_TMO], 1u); break; } }
    }
    nloc = mine > 0u ? mine : 1u; nx = cnt > 0u ? cnt : 1u;
}
DI void xcd_barrier(const XcdBarrier& b) {
    asm volatile("s_waitcnt vmcnt(0)" ::: "memory");
    __syncthreads();
    if (threadIdx.x == 0) {
        unsigned* bar = b.bar;
        __builtin_amdgcn_s_waitcnt(0);
        unsigned nloc = b.st[0], nx = b.st[1];
        if (nloc == 0u) { xcd_barrier_complete(bar, b.x, nloc, nx); b.st[0] = nloc; b.st[1] = nx; }
        const unsigned old = xb_add(&bar[XB_XSUB(b.x)], 1u);
        const unsigned gen = old / nloc;
        if (old + 1u == (gen + 1u) * nloc) {
            __builtin_amdgcn_fence(__ATOMIC_RELEASE, "agent");
            asm volatile("s_waitcnt vmcnt(0)" ::: "memory");
            const unsigned og = xb_add(&bar[XB_TOP], 1u);
            const unsigned tg = og / nx;
            if (og + 1u == (tg + 1u) * nx) xb_add(&bar[XB_TOPGEN], 1u);
            else XB_SPIN(xb_ld(&bar[XB_TOPGEN]) == tg, bar);
            __builtin_amdgcn_fence(__ATOMIC_ACQUIRE, "agent");
            xb_add(&bar[XB_XGEN(b.x)], 1u);
            asm volatile("s_waitcnt vmcnt(0)" ::: "memory");
        } else {
            XB_SPIN(xb_ld(&bar[XB_XGEN(b.x)]) == gen, bar);
            __builtin_amdgcn_fence(__ATOMIC_ACQUIRE, "agent");
            asm volatile("s_waitcnt vmcnt(0)" ::: "memory");
        }
    }
    __syncthreads();
}

enum Op { OP_PRO = 0, OP_NORM, OP_FFN_IN, OP_FFN_OUT, OP_CONV_IN, OP_CONV_EW, OP_CONV_OUT, OP_NSA_IN, OP_NSA_PREP, OP_CMP1, OP_CMP2, OP_ATTN, OP_NSA_OUT };

__global__ void __launch_bounds__(512) mk_fwd(Args a) {
    extern __shared__ __attribute__((aligned(16))) unsigned char lds_raw[];
    LAS unsigned char* lds = (LAS unsigned char*)lds_raw;
    const int G = gridDim.x;
    if (threadIdx.x < 2) ((LAS unsigned*)(lds + LDS_BARST))[threadIdx.x] = 0u;
    __syncthreads();
    const unsigned bar_x = xb_xcc_id();
    if (a.ph_hi - a.ph_lo > 1 && threadIdx.x == 0) (void)xb_add((unsigned*)(a.ws + WS_BAR) + XB_XCNT(bar_x), 1u);

    for (int pi = a.ph_lo; pi < a.ph_hi; ++pi) {
        const int phr = PROG[pi], ph = phr & 63;
#ifdef PROBE_BUILD
        const bool dummy = (phr & 64) != 0;
#else
        constexpr bool dummy = false;
#endif
        int tid = threadIdx.x; asm volatile("" : "+v"(tid));
        const int lane = tid & 63, wid = __builtin_amdgcn_readfirstlane(tid >> 6);
        { size_t z = 0; asm volatile("" : "+s"(z)); a.ws = a.ws0 + z; }
        float* mod = (float*)(a.ws + WS_MOD);
        bf16_t* HB = (bf16_t*)(a.ws + WS_HB); bf16_t* HID = (bf16_t*)(a.ws + WS_HID);
        int op, layer = 0, sub = 0;
        if (ph == 0) op = OP_PRO;
        else if (ph == 63) op = 99;
        else if (ph == 62) op = 98;
        else if (ph == 61) op = 97;
        else {
            int p = ph - 1, s;
            if (p < 10) { layer = 0; s = p; } else if (p < 23) { layer = 1; s = p - 10; } else if (p < 33) { layer = 2; s = p - 23; } else { layer = 3; s = p - 33; }
            if ((layer & 1) == 0) {
                switch (s) { case 0: op = OP_NORM; sub = 0; break; case 1: op = OP_FFN_IN; sub = 0; break; case 2: op = OP_FFN_OUT; sub = 0; break; case 3: op = OP_NORM; sub = 1; break;
                    case 4: op = OP_CONV_IN; break; case 5: op = OP_CONV_EW; break; case 6: op = OP_CONV_OUT; sub = 1; break; case 7: op = OP_NORM; sub = 2; break; case 8: op = OP_FFN_IN; sub = 1; break; default: op = OP_FFN_OUT; sub = 2; break; }
            } else {
                switch (s) { case 0: op = OP_NORM; sub = 0; break; case 1: op = OP_FFN_IN; sub = 0; break; case 2: op = OP_FFN_OUT; sub = 0; break; case 3: op = OP_NORM; sub = 1; break;
                    case 4: op = OP_NSA_IN; break; case 5: op = OP_NSA_PREP; break; case 6: op = OP_CMP1; break; case 7: op = OP_CMP2; break; case 8: op = OP_ATTN; break; case 9: op = OP_NSA_OUT; sub = 1; break;
                    case 10: op = OP_NORM; sub = 2; break; case 11: op = OP_FFN_IN; sub = 1; break; default: op = OP_FFN_OUT; sub = 2; break; }
            }
        }
        const bool fuse = (G == 256);
        if (op == OP_NORM && fuse && !(layer == 0 && sub == 0)) continue;
        const int lj = layer >> 1;
        const float* modL = mod + (size_t)layer * 2 * 9216;
        const bool first = (layer == 0 && (op == OP_NORM || op == OP_FFN_IN || op == OP_FFN_OUT) && sub == 0);
        const float* xsrc = first ? a.x : a.out;

        switch (op) {
#ifndef SKIP_PRO
        case OP_PRO: phase_prologue(a, lds, tid, wid, lane, dummy); break;
#endif
        case OP_NORM: phase_norm(xsrc, a.norm_g + (size_t)(layer * 3 + sub) * DM, modL, sub, HB, wid, lane); break;
        case OP_FFN_IN: {
            const int which = sub;
            pg8::Gemm g{HB, (const bf16_t*)(a.ws + WS_WFI) + (size_t)(layer * 2 + which) * FF2 * DM, DM, DM, 30, 0};
            pg8::StaticOrder S; S.init(TOK, FF2, G, (int)blockIdx.x);
            pg8::EpiSwiGLU E{HID};
            pg8::gemm_phase<pg8::EpiSwiGLU, true>(lds, g, S, E, tid);
        } break;
        case OP_FFN_OUT: case OP_CONV_OUT: case OP_NSA_OUT: {
            pg8::Gemm g;
            if (op == OP_FFN_OUT) g = pg8::Gemm{HID, (const bf16_t*)(a.ws + WS_WFO) + (size_t)(layer * 2 + (sub ? 1 : 0)) * DM * FF, FF, FF, 30, 0};
            else if (op == OP_CONV_OUT) g = pg8::Gemm{HB, (const bf16_t*)(a.ws + WS_WCO) + (size_t)lj * DM * DM, DM, DM, 30, 0};
            else g = pg8::Gemm{HB, (const bf16_t*)(a.ws + WS_WNO) + (size_t)lj * DM * DM, DM, DM, 30, 0};
            pg8::StaticOrder S; S.init(TOK, DM, G, (int)blockIdx.x);
            float* outp = dummy ? (float*)(a.ws + WS_DUMMY) : a.out;
            const float coef = op == OP_FFN_OUT ? 0.5f : 1.0f;
            const bool lastres = (layer == 3 && sub == 2);
            if (fuse && !lastres) {
                const int nl = sub == 2 ? layer + 1 : layer, ns = sub == 2 ? 0 : sub + 1;
                pg8::EpiResNorm E{xsrc, outp, modL + (sub * 3 + 2) * 1024, a.norm_g + (size_t)(nl * 3 + ns) * DM, mod + (size_t)nl * 2 * 9216 + (ns * 3) * 1024,
                                  dummy ? (bf16_t*)(a.ws + WS_DUMMY + 64 * MiB - 34 * MiB) : HB, (float*)(a.ws + WS_XS), (unsigned*)(a.ws + WS_CNT) + (size_t)((layer * 3 + sub) + (dummy ? 12 : 0)) * 64 * 16, coef, 0};
                pg8::gemm_phase<pg8::EpiResNorm, false>(lds, g, S, E, tid);
            } else {
                pg8::EpiRes E{xsrc, outp, modL + (sub * 3 + 2) * 1024, coef};
                pg8::gemm_phase<pg8::EpiRes, false>(lds, g, S, E, tid);
            }
        } break;
        case OP_CONV_IN: {
            pg8::Gemm g{HB, (const bf16_t*)(a.ws + WS_WCI) + (size_t)lj * 3072 * DM, DM, DM, 30, 0};
            pg8::StaticOrder S; S.init(TOK, 3072, G, (int)blockIdx.x);
            pg8::EpiConvIn E{HID, HID + (size_t)TOK * DM};
            pg8::gemm_phase<pg8::EpiConvIn, true>(lds, g, S, E, tid);
        } break;
        case OP_CONV_EW: phase_conv_ew(HID, HID + (size_t)TOK * DM, a.conv_w + (size_t)lj * 3 * DM, HB, tid); break;
        case OP_NSA_IN: {
            pg8::Gemm g{HB, (const bf16_t*)(a.ws + WS_WNI) + (size_t)lj * NSA_P * DM, DM, DM, 30, 0};
            pg8::StaticOrder S; S.init(TOK, NSA_P, G, (int)blockIdx.x);
            pg8::EpiPlain E{HID, NSA_P};
            pg8::gemm_phase<pg8::EpiPlain, true>(lds, g, S, E, tid);
        } break;
#ifndef SKIP_PREP
        case OP_NSA_PREP: phase_nsa_prep(a, lj, lds, tid); break;
#endif
        case OP_CMP1: {
            pg8::Gemm g{(const bf16_t*)(a.ws + WS_KCT), (const bf16_t*)(a.ws + WS_WC1) + (size_t)lj * 2 * 512 * 1024, 1024, 1024, 4, (size_t)512 * 1024};
            pg8::StaticOrder S; S.init(8192, 512, G, (int)blockIdx.x);
            pg8::EpiCmp E{(float*)(a.ws + WS_Y1)};
            pg8::gemm_phase<pg8::EpiCmp, false>(lds, g, S, E, tid);
        } break;
        case OP_CMP2: phase_cmp2(a, lj, lds, tid, wid, lane); break;
#ifndef SKIP_ATTN
        case OP_ATTN: phase_attn(a, lds, tid, wid, lane); break;
#endif
#ifdef SELFTEST
        case 98: phase_selftest(a, lds, wid, lane); break;
        case 97: { const unsigned* fl = (const unsigned*)(a.ws + WS_FLAG); const unsigned bad = __hip_atomic_load(fl, __ATOMIC_RELAXED, __HIP_MEMORY_SCOPE_AGENT), tot = __hip_atomic_load(fl + 1, __ATOMIC_RELAXED, __HIP_MEMORY_SCOPE_AGENT);
                   if (blockIdx.x == 0 && (tot != 2u * 8u * 144u || bad * SELFTEST > tot)) a.out[tid] = __builtin_nanf(""); } break;
#endif
        default: break;
        }
        if (pi + 1 < a.ph_hi) {
            if (pi == a.ph_lo) { __syncthreads(); cg::this_grid().sync(); }
            else { XcdBarrier xb; xb.bar = (unsigned*)(a.ws + WS_BAR); xb.x = bar_x; xb.st = (volatile LAS unsigned*)(lds + LDS_BARST); xcd_barrier(xb); }
        }
    }
}

extern "C" void kernel_launch(void* const* d_in, const int* in_sizes, int n_in, void* d_out, int out_size, void* d_ws, size_t ws_size, hipStream_t stream) {
    static int grid = 0;
    if (grid == 0) {
        int dev = 0, cus = 0, per_cu = 0;
        if (n_in != 18 || ws_size < WS_END) { fprintf(stderr, "kernel_launch: unexpected n_in %d / ws %zu\n", n_in, ws_size); grid = -1; return; }
        hipGetDevice(&dev);
        hipDeviceGetAttribute(&cus, hipDeviceAttributeMultiprocessorCount, dev);
        hipFuncSetAttribute((const void*)mk_fwd, hipFuncAttributeMaxDynamicSharedMemorySize, LDS_BYTES);
        hipOccupancyMaxActiveBlocksPerMultiprocessor(&per_cu, (const void*)mk_fwd, 512, LDS_BYTES);
        if (per_cu < 1) per_cu = 1;
        grid = cus * per_cu;
        (void)hipGetLastError();
    }
    if (grid < 0) return;
    hipMemsetAsync(d_ws, 0, WS_ZERO_BYTES, stream);
    Args a{};
    a.x = (const float*)d_in[0]; a.c = (const float*)d_in[1]; a.norm_g = (const float*)d_in[2]; a.ada_w = (const float*)d_in[3]; a.ada_b = (const float*)d_in[4];
    a.ffn_w_in = (const float*)d_in[5]; a.ffn_w_out = (const float*)d_in[6]; a.conv_w_in = (const float*)d_in[7]; a.conv_w = (const float*)d_in[8]; a.conv_w_out = (const float*)d_in[9];
    a.nsa_w_in = (const float*)d_in[10]; a.cmp_pos = (const float*)d_in[11]; a.cmp_w1 = (const float*)d_in[12]; a.cmp_w2 = (const float*)d_in[13];
    a.q_gain = (const float*)d_in[14]; a.k_gain = (const float*)d_in[15]; a.nsa_w_out = (const float*)d_in[16]; a.rel_bias = (const float*)d_in[17];
    a.out = (float*)d_out; a.ws = (unsigned char*)d_ws; a.ws0 = (unsigned char*)d_ws;
#if MK_MULTI
    for (int ph = 0; ph < NPH; ++ph) { a.ph_lo = ph; a.ph_hi = ph + 1; hipLaunchKernelGGL(mk_fwd, dim3(grid), dim3(512), LDS_BYTES, stream, a); }
#else
    a.ph_lo = 0; a.ph_hi = NPH;
    void* args[] = {&a};
    hipError_t e = hipLaunchCooperativeKernel((const void*)mk_fwd, dim3(grid), dim3(512), args, LDS_BYTES, stream);
    if (e != hipSuccess) fprintf(stderr, "cooperative launch failed: %s (grid %d)\n", hipGetErrorString(e), grid);
#endif
}
```
